# Optimizing an MI355X kernel written in HIP

```python
import math
import jax, jax.numpy as jnp
from jax import lax
import numpy as np

D_MODEL = 1024
BATCH = 4
SEQ = 4096
DEPTH = 1
DEC_BATCH = 32
DEC_SEQ = 4
PAST_LEN = 8192
PAGE_SIZE = 128

A_HEADS = 8
A_HEAD_DIM = 64
A_WIDTH = A_HEADS * A_HEAD_DIM
B_HEADS = 4
B_KEY_DIM = 128
B_VAL_DIM = 128
B_KEY_WIDTH = B_HEADS * B_KEY_DIM
B_WIDTH = B_HEADS * B_VAL_DIM
MIX_WIDTH = A_WIDTH + B_WIDTH
PROJ_SPLITS = (A_WIDTH, A_WIDTH, A_WIDTH, B_KEY_WIDTH, B_KEY_WIDTH, B_WIDTH, B_WIDTH)
IN_WIDTH = 3 * A_WIDTH + 2 * B_KEY_WIDTH + 2 * B_WIDTH
MOBA_BLOCK = 256
MOBA_TOPK = 3
Q_CHUNK = 64
HG_CHUNK = 16
N_BUCKETS = 32
REL_MAX_DIST = 4096
D_FF = 2816
NORM_EPS = 1e-6
NEG_INF = -1e30

kernel_name = 'hymba_moba_hgrn2_macaron_step'


def rms_norm(x, gain):
    xf = x.astype(jnp.float32)
    y = xf * lax.rsqrt(jnp.mean(xf * xf, axis=-1, keepdims=True) + NORM_EPS)
    return (y * gain.astype(jnp.float32)).astype(x.dtype)


def swiglu(x, w_gate, w_up, w_down):
    return (jax.nn.silu(x @ w_gate) * (x @ w_up)) @ w_down


def rel_bucket(dist):
    max_exact = N_BUCKETS // 2
    n = jnp.maximum(dist, 0)
    nf = jnp.maximum(n, 1).astype(jnp.float32)
    large = max_exact + (jnp.log(nf / max_exact) / math.log(REL_MAX_DIST / max_exact)
                         * (N_BUCKETS - max_exact)).astype(jnp.int32)
    large = jnp.minimum(large, N_BUCKETS - 1)
    return jnp.where(n < max_exact, n, large)


def project(h, w_in, q_gain, k_gain, lower_bound):
    b, t, _ = h.shape
    z = h @ w_in
    offsets = [int(o) for o in np.cumsum(PROJ_SPLITS)[:-1]]
    qa, ka, va, qb, fb, ib, gb = jnp.split(z, offsets, axis=-1)
    qa = rms_norm(qa.reshape(b, t, A_HEADS, A_HEAD_DIM), q_gain)
    ka = rms_norm(ka.reshape(b, t, A_HEADS, A_HEAD_DIM), k_gain)
    va = va.reshape(b, t, A_HEADS, A_HEAD_DIM)
    lb = lower_bound.astype(jnp.float32)
    forget = lb + (1.0 - lb) * jax.nn.sigmoid(fb.astype(jnp.float32))
    log_f = jnp.log(forget).reshape(b, t, B_HEADS, B_KEY_DIM)
    kb = (1.0 - forget).reshape(b, t, B_HEADS, B_KEY_DIM)
    qb = jax.nn.silu(qb).reshape(b, t, B_HEADS, B_KEY_DIM)
    ib = ib.reshape(b, t, B_HEADS, B_VAL_DIM)
    return qa, ka, va, qb, kb, ib, log_f, gb


def hgrn2_chunked(q, k, v, log_f, s0):
    b, t, h, _ = q.shape
    c = min(HG_CHUNK, t)
    n = -(-t // c)
    pad = n * c - t

    def prep(a):
        a = jnp.pad(a.astype(jnp.float32), ((0, 0), (0, pad), (0, 0), (0, 0)))
        return a.reshape(b, n, c, h, a.shape[-1]).transpose(1, 0, 3, 2, 4)

    qc, kc, vc, gc = prep(q), prep(k), prep(v), prep(log_f)
    causal = jnp.tril(jnp.ones((c, c), dtype=bool))[:, :, None]

    def step(s, inp):
        qq, kk, vv, gg = inp
        cum = jnp.cumsum(gg, axis=2)
        inter = jnp.einsum('bhtk,bhkv->bhtv', qq * jnp.exp(cum), s)
        diff = cum[:, :, :, None, :] - cum[:, :, None, :, :]
        decay = jnp.exp(jnp.where(causal, diff, -jnp.inf))
        scores = jnp.einsum('bhtk,bhtsk,bhsk->bhts', qq, decay, kk)
        intra = jnp.einsum('bhts,bhsv->bhtv', scores, vv)
        last = cum[:, :, -1:, :]
        s_new = jnp.exp(last[:, :, 0, :])[..., None] * s + jnp.einsum(
            'bhsk,bhsv->bhkv', kk * jnp.exp(last - cum), vv)
        return s_new, inter + intra

    s_fin, out = lax.scan(step, s0.astype(jnp.float32), (qc, kc, vc, gc))
    out = out.transpose(1, 0, 3, 2, 4).reshape(b, n * c, h, -1)[:, :t]
    return out, s_fin


def moba_attend(q, q_pos, k_sel, v_sel, kpos_sel, sel_valid, k_own, v_own, kpos_own, rel_table):
    scale = A_HEAD_DIM ** -0.5
    table_t = rel_table.astype(jnp.float32).T
    own_dist = q_pos[:, None] - kpos_own[None, :]
    own_logits = jnp.einsum('bhtd,bhnd->bhtn', q, k_own, preferred_element_type=jnp.float32) * scale
    own_logits = own_logits + jnp.take(table_t, rel_bucket(own_dist), axis=1)[None]
    own_logits = jnp.where((own_dist >= 0)[None, None], own_logits, NEG_INF)
    if k_sel is None:
        p = jax.nn.softmax(own_logits, axis=-1)
        return jnp.einsum('bhtn,bhnd->bhtd', p.astype(v_own.dtype), v_own,
                          preferred_element_type=jnp.float32)
    heads = jnp.arange(q.shape[1])[None, :, None, None, None]
    sel_dist = q_pos[None, None, :, None, None] - kpos_sel
    sel_logits = jnp.einsum('bhtd,bhtjld->bhtjl', q, k_sel, preferred_element_type=jnp.float32) * scale
    sel_logits = sel_logits + table_t[heads, rel_bucket(sel_dist)]
    sel_logits = jnp.where(sel_valid, sel_logits, NEG_INF)
    b, h, t, j, L = sel_logits.shape
    logits = jnp.concatenate([sel_logits.reshape(b, h, t, j * L), own_logits], axis=-1)
    p = jax.nn.softmax(logits, axis=-1)
    p_sel = p[..., :j * L].reshape(b, h, t, j, L)
    p_own = p[..., j * L:]
    return (jnp.einsum('bhtjl,bhtjld->bhtd', p_sel.astype(v_sel.dtype), v_sel,
                       preferred_element_type=jnp.float32)
            + jnp.einsum('bhtn,bhnd->bhtd', p_own.astype(v_own.dtype), v_own,
                         preferred_element_type=jnp.float32))


def moba_prompt(q, k, v, rel_table):
    b, s, h, d = q.shape
    nb = -(-s // MOBA_BLOCK)
    pad = nb * MOBA_BLOCK - s
    qh = q.transpose(0, 2, 1, 3)
    kh = jnp.pad(k.transpose(0, 2, 1, 3), ((0, 0), (0, 0), (0, pad), (0, 0)))
    vh = jnp.pad(v.transpose(0, 2, 1, 3), ((0, 0), (0, 0), (0, pad), (0, 0)))
    k_blocks = kh.reshape(b, h, nb, MOBA_BLOCK, d)
    v_blocks = vh.reshape(b, h, nb, MOBA_BLOCK, d)
    n_full = jnp.arange(s) // MOBA_BLOCK
    n_sel = min(MOBA_TOPK, nb - 1)
    offs = jnp.arange(MOBA_BLOCK)
    bi = jnp.arange(b)[:, None, None, None]
    hi = jnp.arange(h)[None, :, None, None]
    if n_sel > 0:
        k_mean = jnp.mean(k_blocks.astype(jnp.float32), axis=3)
        gate = jnp.einsum('bhsd,bhnd->bhsn', qh.astype(jnp.float32), k_mean)
        gate = jnp.where(jnp.arange(nb)[None, :] < n_full[:, None], gate, -jnp.inf)
        _, sel_idx = lax.top_k(gate, n_sel)
        sel_valid = jnp.arange(n_sel)[None, :] < n_full[:, None]

    def chunk(ci):
        c0 = ci * Q_CHUNK
        qc = lax.dynamic_slice_in_dim(qh, c0, Q_CHUNK, axis=2)
        q_pos = c0 + jnp.arange(Q_CHUNK)
        own_start = (c0 // MOBA_BLOCK) * MOBA_BLOCK
        k_own = lax.dynamic_slice_in_dim(kh, own_start, MOBA_BLOCK, axis=2)
        v_own = lax.dynamic_slice_in_dim(vh, own_start, MOBA_BLOCK, axis=2)
        kpos_own = own_start + offs
        if n_sel == 0:
            return moba_attend(qc, q_pos, None, None, None, None, k_own, v_own, kpos_own, rel_table)
        idx = lax.dynamic_slice_in_dim(sel_idx, c0, Q_CHUNK, axis=2)
        valid = lax.dynamic_slice_in_dim(sel_valid, c0, Q_CHUNK, axis=0)[None, None, :, :, None]
        k_sel = k_blocks[bi, hi, idx]
        v_sel = v_blocks[bi, hi, idx]
        kpos_sel = idx[..., None] * MOBA_BLOCK + offs
        return moba_attend(qc, q_pos, k_sel, v_sel, kpos_sel, valid, k_own, v_own, kpos_own, rel_table)

    out = lax.map(chunk, jnp.arange(s // Q_CHUNK))
    return out.transpose(1, 0, 3, 2, 4).reshape(b, s, h, d)


def moba_sample(q, k_new, v_new, cache_k, cache_v, page_table, rel_table):
    db, t, h, d = q.shape
    k_past = cache_k[page_table].reshape(db, -1, h, d)
    v_past = cache_v[page_table].reshape(db, -1, h, d)
    past = k_past.shape[1]
    n_full = past // MOBA_BLOCK
    own_start = n_full * MOBA_BLOCK
    q_pos = past + jnp.arange(t)
    qh = q.transpose(0, 2, 1, 3)
    k_own = jnp.concatenate([k_past[:, own_start:], k_new], axis=1).transpose(0, 2, 1, 3)
    v_own = jnp.concatenate([v_past[:, own_start:], v_new], axis=1).transpose(0, 2, 1, 3)
    kpos_own = jnp.concatenate([jnp.arange(own_start, past), q_pos])
    n_sel = min(MOBA_TOPK, n_full)
    if n_sel == 0:
        out = moba_attend(qh, q_pos, None, None, None, None, k_own, v_own, kpos_own, rel_table)
        return out.transpose(0, 2, 1, 3)
    k_blocks = k_past[:, :own_start].reshape(db, n_full, MOBA_BLOCK, h, d)
    v_blocks = v_past[:, :own_start].reshape(db, n_full, MOBA_BLOCK, h, d)
    k_mean = jnp.mean(k_blocks.astype(jnp.float32), axis=2)
    gate = jnp.einsum('bhtd,bnhd->bhtn', qh.astype(jnp.float32), k_mean)
    _, idx = lax.top_k(gate, n_sel)
    bi = jnp.arange(db)[:, None, None, None]
    hi = jnp.arange(h)[None, :, None, None]
    k_sel = k_blocks[bi, idx, :, hi]
    v_sel = v_blocks[bi, idx, :, hi]
    kpos_sel = idx[..., None] * MOBA_BLOCK + jnp.arange(MOBA_BLOCK)
    valid = jnp.ones((1, 1, 1, 1, 1), dtype=bool)
    out = moba_attend(qh, q_pos, k_sel, v_sel, kpos_sel, valid, k_own, v_own, kpos_own, rel_table)
    return out.transpose(0, 2, 1, 3)


def merge_groups(attn, rec, gate, out_gain, w_out):
    b, t = gate.shape[:2]
    rec = rms_norm(rec, out_gain.reshape(B_HEADS, B_VAL_DIM)).reshape(b, t, B_WIDTH).astype(gate.dtype)
    rec = rec * jax.nn.silu(gate)
    mixed = jnp.concatenate([attn.reshape(b, t, A_WIDTH).astype(gate.dtype), rec], axis=-1)
    return mixed @ w_out


def setup_inputs(seed: int = 0) -> dict:
    key = jax.random.key(seed)
    ks = jax.random.split(key, 24)
    n_pages = PAST_LEN // PAGE_SIZE
    n_used = DEC_BATCH * n_pages
    n_phys = n_used + n_used // 4

    def nrm(k, shape, scale):
        return scale * jax.random.normal(k, shape, jnp.float32)

    def gain(k, shape):
        return 1.0 + 0.02 * jax.random.normal(k, shape, jnp.float32)

    page_table = jax.random.permutation(ks[5], n_phys)[:n_used].reshape(DEC_BATCH, n_pages).astype(jnp.int32)
    return {
        'x_prompt': nrm(ks[0], (BATCH, SEQ, D_MODEL), 1.0),
        'x_sample': nrm(ks[1], (DEC_BATCH, DEC_SEQ, D_MODEL), 1.0),
        'cache_k': nrm(ks[2], (DEPTH, n_phys, PAGE_SIZE, A_HEADS, A_HEAD_DIM), 1.0),
        'cache_v': nrm(ks[3], (DEPTH, n_phys, PAGE_SIZE, A_HEADS, A_HEAD_DIM), 1.0),
        'state_hgrn': nrm(ks[4], (DEPTH, DEC_BATCH, B_HEADS, B_KEY_DIM, B_VAL_DIM), 0.5),
        'page_table': page_table,
        'rel_bias_table': nrm(ks[6], (N_BUCKETS, A_HEADS), 0.5),
        'lb_logits': nrm(ks[7], (DEPTH + 1, B_KEY_WIDTH), 1.0),
        'ffn1_norm': gain(ks[8], (DEPTH, D_MODEL)),
        'ffn1_gate': nrm(ks[9], (DEPTH, D_MODEL, D_FF), D_MODEL ** -0.5),
        'ffn1_up': nrm(ks[10], (DEPTH, D_MODEL, D_FF), D_MODEL ** -0.5),
        'ffn1_down': nrm(ks[11], (DEPTH, D_FF, D_MODEL), D_FF ** -0.5),
        'mix_norm': gain(ks[12], (DEPTH, D_MODEL)),
        'w_in': nrm(ks[13], (DEPTH, D_MODEL, IN_WIDTH), D_MODEL ** -0.5),
        'q_norm': gain(ks[14], (DEPTH, A_HEAD_DIM)),
        'k_norm': gain(ks[15], (DEPTH, A_HEAD_DIM)),
        'hgrn_out_norm': gain(ks[16], (DEPTH, B_WIDTH)),
        'w_out': nrm(ks[17], (DEPTH, MIX_WIDTH, D_MODEL), MIX_WIDTH ** -0.5),
        'ffn2_norm': gain(ks[18], (DEPTH, D_MODEL)),
        'ffn2_gate': nrm(ks[19], (DEPTH, D_MODEL, D_FF), D_MODEL ** -0.5),
        'ffn2_up': nrm(ks[20], (DEPTH, D_MODEL, D_FF), D_MODEL ** -0.5),
        'ffn2_down': nrm(ks[21], (DEPTH, D_FF, D_MODEL), D_FF ** -0.5),
    }


def reference(x_prompt, x_sample, cache_k, cache_v, state_hgrn, page_table, rel_bias_table,
              lb_logits, ffn1_norm, ffn1_gate, ffn1_up, ffn1_down, mix_norm, w_in, q_norm,
              k_norm, hgrn_out_norm, w_out, ffn2_norm, ffn2_gate, ffn2_up, ffn2_down):
    lower_bounds = jnp.cumsum(jax.nn.softmax(lb_logits.astype(jnp.float32), axis=0), axis=0)
    yp, ys = x_prompt, x_sample
    kp_rows, vp_rows, sp_rows, ks_rows, vs_rows, ss_rows = [], [], [], [], [], []
    for l in range(DEPTH):
        yp = yp + 0.5 * swiglu(rms_norm(yp, ffn1_norm[l]), ffn1_gate[l], ffn1_up[l], ffn1_down[l])
        ys = ys + 0.5 * swiglu(rms_norm(ys, ffn1_norm[l]), ffn1_gate[l], ffn1_up[l], ffn1_down[l])

        qa, ka, va, qb, kb, ib, lf, gb = project(rms_norm(yp, mix_norm[l]), w_in[l], q_norm[l],
                                                 k_norm[l], lower_bounds[l])
        attn = moba_prompt(qa, ka, va, rel_bias_table)
        s0 = jnp.zeros((yp.shape[0], B_HEADS, B_KEY_DIM, B_VAL_DIM), jnp.float32)
        rec, s_fin = hgrn2_chunked(qb, kb, ib, lf, s0)
        yp = yp + merge_groups(attn, rec, gb, hgrn_out_norm[l], w_out[l])
        kp_rows.append(ka)
        vp_rows.append(va)
        sp_rows.append(s_fin.astype(state_hgrn.dtype))

        qa, ka, va, qb, kb, ib, lf, gb = project(rms_norm(ys, mix_norm[l]), w_in[l], q_norm[l],
                                                 k_norm[l], lower_bounds[l])
        attn = moba_sample(qa, ka, va, cache_k[l], cache_v[l], page_table, rel_bias_table)
        rec, s_new = hgrn2_chunked(qb, kb, ib, lf, state_hgrn[l])
        ys = ys + merge_groups(attn, rec, gb, hgrn_out_norm[l], w_out[l])
        ks_rows.append(ka)
        vs_rows.append(va)
        ss_rows.append(s_new.astype(state_hgrn.dtype))

        yp = yp + 0.5 * swiglu(rms_norm(yp, ffn2_norm[l]), ffn2_gate[l], ffn2_up[l], ffn2_down[l])
        ys = ys + 0.5 * swiglu(rms_norm(ys, ffn2_norm[l]), ffn2_gate[l], ffn2_up[l], ffn2_down[l])

    k_prompt = jnp.stack(kp_rows)
    v_prompt = jnp.stack(vp_rows)
    state_prompt = jnp.stack(sp_rows)
    k_sample = jnp.stack(ks_rows)
    v_sample = jnp.stack(vs_rows)
    state_sample = jnp.stack(ss_rows)
    return (yp, ys, k_prompt, v_prompt, state_prompt, k_sample, v_sample, state_sample)
```

```cpp
#include <hip/hip_runtime.h>
#include <cstdio>
#include <cstdint>
namespace pg8 {
#define PG8_LAS __attribute__((address_space(3)))
typedef unsigned short bf16_t;
typedef short bf16x8 __attribute__((ext_vector_type(8)));
typedef float f32x4 __attribute__((ext_vector_type(4)));
typedef unsigned u32x4 __attribute__((ext_vector_type(4)));
constexpr int BM = 256, BK = 64, HALF = 128, HTB = HALF * BK * 2  , STAGE_BYTES = 8 * HTB, NXCD = 8, WGM = 8;

__host__ __device__ __forceinline__ int lds_byte(int r, int c) { const int st = (r >> 4) * 2 + (c >> 5), rr = r & 15, cc = c & 31, ob = rr * 64 + cc * 2; return st * 1024 + (ob ^ (((ob >> 9) & 1) << 5)); }
__host__ __device__ __forceinline__ void stage_rc(int b, int& R, int& C) { const int st = b / 1024, sb = b % 1024, swz = sb ^ (((sb >> 9) & 1) << 5); R = (st >> 1) * 16 + swz / 64; C = (st & 1) * 32 + (swz % 64) / 2; }
__host__ __device__ __forceinline__ int perm32(int rho) { const int n = rho >> 4, i = rho & 15; return 8 * (i >> 2) + 4 * n + (i & 3); }

struct Unit { int pm, pn; };
struct Gemm { const bf16_t* A; const bf16_t* Bt; int M, N, K; };

struct StaticOrder {
    int nM, nN, nwg, G, c;
    __host__ __device__ void init(int M, int N, int G_, int c_) { nM = M / BM; nN = N / BM; nwg = nM * nN; G = G_; c = c_; }
    __host__ __device__ bool next(int i, Unit& u) const {
        const long L = (long)i * G + c; if (L >= nwg) return false;
        int wgid = (int)L; { const int q = nwg / NXCD, r = nwg % NXCD, xcd = wgid % NXCD, off = wgid / NXCD; wgid = (xcd < r ? xcd * (q + 1) : r * (q + 1) + (xcd - r) * q) + off; }
        const int nig = WGM * nN, gid = wgid / nig, fm = gid * WGM, gsz = (nM - fm) < WGM ? (nM - fm) : WGM;
        u.pm = fm + ((wgid % nig) % gsz); u.pn = (wgid % nig) / gsz; return true;
    }
    __device__ __forceinline__ void a_ready(const Unit&) const {}
    __device__ __forceinline__ void done(const Unit&) const {}
};

__device__ __forceinline__ unsigned cvt_pk_bf16(float lo, float hi) { unsigned r; asm volatile("v_cvt_pk_bf16_f32 %0, %1, %2" : "=v"(r) : "v"(lo), "v"(hi)); return r; }
typedef float f32x2 __attribute__((ext_vector_type(2)));
struct EpiF32 {
    static constexpr bool PERM = true, AFTER_DRAIN = false;
    float* O; int ldc;
    __device__ __forceinline__ void operator()(const f32x4 (&acc)[2][2][4][2], const Unit& u, int wr, int wc, int fr, int fq) const {
        const int row0 = u.pm * BM + wr * 64 + fr; const int col0 = u.pn * BM + wc * 32 + 8 * fq;
#pragma unroll
        for (int ai = 0; ai < 2; ++ai)
#pragma unroll
            for (int m = 0; m < 4; ++m) { float* rowp = O + (size_t)(row0 + ai * HALF + m * 16) * ldc + col0;
#pragma unroll
                for (int bj = 0; bj < 2; ++bj) { *(f32x4*)(rowp + bj * HALF) = acc[ai][bj][m][0]; *(f32x4*)(rowp + bj * HALF + 4) = acc[ai][bj][m][1]; } }
    }
};
template <class Epi, class Sched, bool ALIGN_EPI = false, bool SP2 = false>
__device__ __forceinline__ void gemm_phase(PG8_LAS unsigned char* lds, const Gemm g, const Sched& S, const Epi& E) {
    const int tid = threadIdx.x, wid = __builtin_amdgcn_readfirstlane(tid >> 6), lane = tid & 63, wr = wid >> 2, wc = wid & 3, fr = lane & 15, fq = lane >> 4;
    const int K = g.K, nt = K / BK;
    unsigned voffA[2], voffB[2];
#pragma unroll
    for (int i = 0; i < 2; ++i) { int R, C; stage_rc(tid * 16 + i * 8192, R, C); const int Rb = Epi::PERM ? ((R & ~31) + perm32(R & 31)) : R;
        voffA[i] = (unsigned)(R * K + C) * 2u; voffB[i] = (unsigned)(Rb * K + C) * 2u; }
    const size_t kstep = (size_t)(BK * 2);
    const size_t hstep = (size_t)HALF * K * 2;
    const size_t tstep = 2 * hstep;
    const unsigned ldsw = (unsigned)wid * 1024u;
    const int aoff = lds_byte(wr * 64 + fr, fq * 8), boff = lds_byte(wc * 32 + fr, fq * 8);
#define PG8_SA(b, h) (((b) * 2 + (h)) * HTB)
#define PG8_SB(b, h) ((4 + (b) * 2 + (h)) * HTB)
#define PG8_STAGE(bufoff, gbase, voff) do { _Pragma("unroll") for (int _i = 0; _i < 2; ++_i) \
        __builtin_amdgcn_global_load_lds((const unsigned*)((const char*)(gbase) + (voff)[_i]), (PG8_LAS unsigned*)(lds + (bufoff) + ldsw + _i * 8192), 16, 0, 0); } while (0)
#define PG8_LDA(dst, b, h) do { _Pragma("unroll") for (int m = 0; m < 4; ++m) _Pragma("unroll") for (int k = 0; k < 2; ++k) dst[m][k] = *(const PG8_LAS bf16x8*)(lds + PG8_SA(b, h) + aoff + m * 2048 + k * 1024); } while (0)
#define PG8_LDB(dst, b, h) do { _Pragma("unroll") for (int n = 0; n < 2; ++n) _Pragma("unroll") for (int k = 0; k < 2; ++k) dst[n][k] = *(const PG8_LAS bf16x8*)(lds + PG8_SB(b, h) + boff + n * 2048 + k * 1024); } while (0)
#define PG8_MMA(ai, bj, At, Bt) do { __builtin_amdgcn_s_setprio(1); _Pragma("unroll") for (int m = 0; m < 4; ++m) _Pragma("unroll") for (int n = 0; n < 2; ++n) _Pragma("unroll") for (int k = 0; k < 2; ++k) \
        acc[ai][bj][m][n] = __builtin_amdgcn_mfma_f32_16x16x32_bf16(Bt[n][k], At[m][k], acc[ai][bj][m][n], 0, 0, 0); __builtin_amdgcn_s_setprio(0); } while (0)
#define PG8_WAIT_V(n) asm volatile("s_waitcnt vmcnt(" #n ")" ::: "memory")
#define PG8_WAIT_L(n) asm volatile("s_waitcnt lgkmcnt(" #n ")" ::: "memory")
#define PG8_BAR __builtin_amdgcn_s_barrier()
#define PG8_SCHED __builtin_amdgcn_sched_barrier(0)
    Unit cur, nxt; int ui = 0;
    if (!S.next(0, cur)) return;
    f32x4 acc[2][2][4][2];
#pragma unroll
    for (int a = 0; a < 2; ++a)
#pragma unroll
        for (int b = 0; b < 2; ++b)
#pragma unroll
            for (int m = 0; m < 4; ++m)
#pragma unroll
                for (int n = 0; n < 2; ++n) acc[a][b][m][n] = (f32x4){0.f, 0.f, 0.f, 0.f};
    bf16x8 At[4][2], B0[2][2], B1[2][2];
    const char* cA = (const char*)g.A + (size_t)cur.pm * tstep; const char* cB = (const char*)g.Bt + (size_t)cur.pn * tstep;
    S.a_ready(cur);
    if constexpr (SP2) {
        PG8_STAGE(PG8_SB(0, 0), cB, voffB); PG8_STAGE(PG8_SB(0, 1), cB + hstep, voffB); PG8_STAGE(PG8_SA(0, 0), cA, voffA); PG8_STAGE(PG8_SA(0, 1), cA + hstep, voffA);
        if (wr == 1) PG8_BAR;
        PG8_WAIT_V(2); PG8_BAR;
        PG8_STAGE(PG8_SB(1, 0), cB + kstep, voffB); PG8_STAGE(PG8_SA(1, 0), cA + kstep, voffA); PG8_STAGE(PG8_SB(1, 1), cB + hstep + kstep, voffB);
        PG8_WAIT_V(6); PG8_BAR;
    } else {
        PG8_STAGE(PG8_SB(0, 0), cB, voffB); PG8_STAGE(PG8_SA(0, 0), cA, voffA); PG8_STAGE(PG8_SB(0, 1), cB + hstep, voffB); PG8_STAGE(PG8_SA(0, 1), cA + hstep, voffA);
        if (wr == 1) PG8_BAR;
        PG8_WAIT_V(4); PG8_BAR;
        PG8_STAGE(PG8_SB(1, 0), cB + kstep, voffB); PG8_STAGE(PG8_SA(1, 0), cA + kstep, voffA); PG8_STAGE(PG8_SB(1, 1), cB + hstep + kstep, voffB);
        PG8_WAIT_V(6); PG8_BAR;
    }
    for (;;) {
        const bool has_next = S.next(ui + 1, nxt);
        const char* nA = has_next ? (const char*)g.A + (size_t)nxt.pm * tstep : cA; const char* nB = has_next ? (const char*)g.Bt + (size_t)nxt.pn * tstep : cB;
        for (int t = 0; t < nt; t += 2) {
            const bool last = (t == nt - 2);
            const char* a1 = cA + (size_t)(t + 1) * kstep;
            const char* a2 = last ? nA : cA + (size_t)(t + 2) * kstep; const char* b2 = last ? nB : cB + (size_t)(t + 2) * kstep;
            const char* a3 = a2 + kstep; const char* b3 = b2 + kstep;
            if (last && has_next) S.a_ready(nxt);
            if constexpr (SP2) {
            PG8_LDB(B0, 0, 0); PG8_LDB(B1, 0, 1); PG8_SCHED; PG8_LDA(At, 0, 0); PG8_STAGE(PG8_SA(1, 1), a1 + hstep, voffA);
            PG8_WAIT_V(8); PG8_WAIT_L(0); PG8_BAR; PG8_MMA(0, 0, At, B0); PG8_MMA(0, 1, At, B1); PG8_BAR; PG8_SCHED;
            PG8_LDA(At, 0, 1); PG8_STAGE(PG8_SB(0, 0), b2, voffB); PG8_STAGE(PG8_SB(0, 1), b2 + hstep, voffB); PG8_STAGE(PG8_SA(0, 0), a2, voffA);
            PG8_WAIT_V(8); PG8_WAIT_L(0); PG8_BAR; PG8_MMA(1, 0, At, B0); PG8_MMA(1, 1, At, B1); PG8_BAR; PG8_SCHED;
            PG8_LDB(B0, 1, 0); PG8_LDB(B1, 1, 1); PG8_SCHED; PG8_LDA(At, 1, 0); PG8_STAGE(PG8_SA(0, 1), a2 + hstep, voffA);
            PG8_WAIT_V(8); PG8_WAIT_L(0); PG8_BAR; PG8_MMA(0, 0, At, B0); PG8_MMA(0, 1, At, B1); PG8_BAR; PG8_SCHED;
            PG8_LDA(At, 1, 1); PG8_STAGE(PG8_SB(1, 0), b3, voffB); PG8_STAGE(PG8_SB(1, 1), b3 + hstep, voffB); PG8_STAGE(PG8_SA(1, 0), a3, voffA);
            PG8_WAIT_V(8); PG8_WAIT_L(0); PG8_BAR; PG8_MMA(1, 0, At, B0); PG8_MMA(1, 1, At, B1); PG8_BAR; PG8_SCHED;
            } else {
            PG8_LDB(B0, 0, 0); PG8_SCHED; PG8_LDA(At, 0, 0); PG8_STAGE(PG8_SA(1, 1), a1 + hstep, voffA);
            PG8_WAIT_L(8); PG8_BAR; PG8_WAIT_L(0); PG8_MMA(0, 0, At, B0); PG8_BAR; PG8_SCHED;
            PG8_LDB(B1, 0, 1); PG8_STAGE(PG8_SB(0, 0), b2, voffB);
            PG8_BAR; PG8_WAIT_L(0); PG8_MMA(0, 1, At, B1); PG8_BAR;
            PG8_LDA(At, 0, 1); PG8_STAGE(PG8_SA(0, 0), a2, voffA);
            PG8_BAR; PG8_WAIT_L(0); PG8_MMA(1, 0, At, B0); PG8_BAR; PG8_SCHED;
            PG8_STAGE(PG8_SB(0, 1), b2 + hstep, voffB);
            PG8_WAIT_V(6); PG8_BAR; PG8_MMA(1, 1, At, B1); PG8_BAR;
            PG8_LDB(B0, 1, 0); PG8_SCHED; PG8_LDA(At, 1, 0); PG8_STAGE(PG8_SA(0, 1), a2 + hstep, voffA);
            PG8_WAIT_L(8); PG8_BAR; PG8_WAIT_L(0); PG8_MMA(0, 0, At, B0); PG8_BAR; PG8_SCHED;
            PG8_LDB(B1, 1, 1); PG8_STAGE(PG8_SB(1, 0), b3, voffB);
            PG8_BAR; PG8_WAIT_L(0); PG8_MMA(0, 1, At, B1); PG8_BAR;
            PG8_LDA(At, 1, 1); PG8_STAGE(PG8_SA(1, 0), a3, voffA);
            PG8_BAR; PG8_WAIT_L(0); PG8_MMA(1, 0, At, B0); PG8_BAR; PG8_SCHED;
            PG8_STAGE(PG8_SB(1, 1), b3 + hstep, voffB);
            PG8_WAIT_V(6); PG8_BAR; PG8_MMA(1, 1, At, B1); PG8_BAR;
            }
        }
        if constexpr (ALIGN_EPI) { if (wr == 0) PG8_BAR; }
        if constexpr (!Epi::AFTER_DRAIN) { E(acc, cur, wr, wc, fr, fq); S.done(cur); }
        if (!has_next) break;
#pragma unroll
        for (int a = 0; a < 2; ++a)
#pragma unroll
            for (int b = 0; b < 2; ++b)
#pragma unroll
                for (int m = 0; m < 4; ++m)
#pragma unroll
                    for (int n = 0; n < 2; ++n) acc[a][b][m][n] = (f32x4){0.f, 0.f, 0.f, 0.f};
        cur = nxt; cA = nA; cB = nB; ++ui;
        if constexpr (ALIGN_EPI) { if (wr == 1) PG8_BAR; }
    }
    PG8_WAIT_V(0);
    if constexpr (!ALIGN_EPI) { if (wr == 0) PG8_BAR; }
    PG8_BAR;
    if constexpr (Epi::AFTER_DRAIN) { E.fused(acc, cur, wr, wc, fr, fq, lds, wid, lane); S.done(cur); }
#undef PG8_SA
#undef PG8_SB
#undef PG8_STAGE
#undef PG8_LDA
#undef PG8_LDB
#undef PG8_MMA
#undef PG8_WAIT_V
#undef PG8_WAIT_L
#undef PG8_BAR
#undef PG8_SCHED
}
}
constexpr int NWAVES = 8;
constexpr int D = 1024, FF = 2816, NGU = 2 * FF, NIN = 3584;
constexpr int PB = 4, PT = 4096, MP = PB * PT;
constexpr int SB = 32, ST = 4, MS = SB * ST;
constexpr int MR = MP + MS;
constexpr int M_ALL = 16640;
constexpr int AH = 8, AD = 64, AW = 512;
constexpr int BH = 4, BKD = 128, BVD = 128, BW = 512;
constexpr int PAST = 8192, PAGE = 128, NPG = 64, MOBA = 256, NBS = PAST / MOBA  , NBP = PT / MOBA  ;
constexpr float EPS = 1e-6f;
constexpr int ZQ = 0, ZK = 512, ZV = 1024, ZQB = 1536, ZFB = 2048, ZIB = 2560, ZGB = 3072;
constexpr size_t OFF_YP = 0, OFF_YS = 16777216, OFF_KP = 16908288, OFF_VP = 25296896, OFF_SP = 33685504, OFF_KS = 33947648, OFF_VS = 34013184, OFF_SS = 34078720, OUT_TOTAL = 36175872;
constexpr size_t MiB = 1u << 20;
constexpr size_t WS_CTL = 0, CTL_ZERO_BYTES = 1 * MiB;
constexpr size_t WS_SMALL = 1 * MiB;
constexpr size_t WS_KMS = 2 * MiB;
constexpr size_t WS_WGU1 = 4 * MiB, WS_WD1 = 15 * MiB, WS_WIN = 21 * MiB, WS_WOUT = 28 * MiB, WS_WGU2 = 30 * MiB, WS_WD2 = 41 * MiB;
constexpr size_t WS_XA = 48 * MiB, WS_MIX = 81 * MiB, WS_H = 114 * MiB, WS_D = 204 * MiB, WS_X1 = 270 * MiB, WS_X2 = 336 * MiB, WS_REC = 402 * MiB, WS_Z = 436 * MiB, WS_GU = 664 * MiB, WS_END = 1024 * MiB;
static_assert(WS_WD2 + (size_t)D * FF * 2 <= WS_XA && WS_XA + (size_t)M_ALL * D * 2 <= WS_MIX && WS_MIX + (size_t)M_ALL * D * 2 <= WS_H && WS_H + (size_t)M_ALL * FF * 2 <= WS_D &&
              WS_D + (size_t)M_ALL * D * 4 <= WS_X1 && WS_X1 + (size_t)M_ALL * D * 4 <= WS_X2 && WS_X2 + (size_t)M_ALL * D * 4 <= WS_REC && WS_REC + (size_t)M_ALL * BW * 4 <= WS_Z &&
              WS_Z + (size_t)M_ALL * NIN * 4 <= WS_GU && WS_GU + (size_t)M_ALL * NGU * 4 <= WS_END, "d_ws map");
constexpr int CW_TMO = 0, CW_CODE = 1, CW_BAR = 4096;
constexpr int RING_OFF = 0, RING_BYTES = 131072, LDSCTL_OFF = RING_BYTES, MISC_OFF = LDSCTL_OFF + 320, LDS_BYTES = 147456;
static_assert(MISC_OFF + 128 <= LDS_BYTES, "LDS map");
#define GAS __attribute__((address_space(1)))
#define LAS __attribute__((address_space(3)))
typedef unsigned short bf16;
typedef unsigned v4u __attribute__((ext_vector_type(4)));
typedef float f32x4 __attribute__((ext_vector_type(4)));
typedef short bf16x8 __attribute__((ext_vector_type(8)));
typedef GAS unsigned gu32;
typedef GAS unsigned long long gu64;
#define RLX_AGENT __ATOMIC_RELAXED, __HIP_MEMORY_SCOPE_AGENT
#define LDS_WAIT() asm volatile("s_waitcnt lgkmcnt(0)" ::: "memory")
#define VM_WAIT() asm volatile("s_waitcnt vmcnt(0)" ::: "memory")
__device__ __forceinline__ unsigned long long rt() { return __builtin_amdgcn_s_memrealtime(); }
__device__ __forceinline__ unsigned f2bf(float f) { unsigned u = __builtin_bit_cast(unsigned, f); return (u + 0x7fffu + ((u >> 16) & 1u)) >> 16; }
__device__ __forceinline__ unsigned pk2(float lo, float hi) { return f2bf(lo) | (f2bf(hi) << 16); }

#define XB_TMO      128
#define XB_XCNT(j)  (256  + 64 * (j))
#define XB_XSUB(j)  (1280 + 64 * (j))
#define XB_XGEN(j)  (2304 + 64 * (j))
#define XB_TOP      3328
#define XB_TOPGEN   3392
#define XCD_BAR_WORDS 3456
#define XB_SPIN_CAP (1u << 18)

__device__ __forceinline__ unsigned xb_ld(unsigned* p)              { return __hip_atomic_load(p, __ATOMIC_RELAXED, __HIP_MEMORY_SCOPE_AGENT); }
__device__ __forceinline__ unsigned xb_add(unsigned* p, unsigned v) { return __hip_atomic_fetch_add(p, v, __ATOMIC_RELAXED, __HIP_MEMORY_SCOPE_AGENT); }
__device__ __forceinline__ unsigned xb_xcc_id() { return (unsigned)__builtin_amdgcn_s_getreg((3 << 11) | 20) & 0xFu; }
#define XB_SPIN(cond, bar) do { unsigned _sp = 0; while (cond) { __builtin_amdgcn_s_sleep(1); \
    if ((++_sp & 255u) == 0u) { if (xb_ld(&(bar)[XB_TMO])) break; if (_sp > XB_SPIN_CAP) { atomicAdd(&(bar)[XB_TMO], 1u); break; } } } } while (0)

struct XcdBarrier {
    unsigned* bar; unsigned x;
    volatile LAS unsigned* st;
};

__device__ __forceinline__ XcdBarrier xcd_barrier_post(unsigned* bar, volatile LAS unsigned* st) {
    XcdBarrier b; b.bar = bar; b.x = xb_xcc_id(); b.st = st;
    if (threadIdx.x == 0) (void)xb_add(&bar[XB_XCNT(b.x)], 1u);
    return b;
}
__device__ __forceinline__ void xcd_barrier_complete(unsigned* bar, unsigned x, unsigned& nloc, unsigned& nx) {
    const unsigned G = gridDim.x * gridDim.y * gridDim.z;
    unsigned sum, cnt, mine, sp = 0u;
    for (;;) {
        sum = 0u; cnt = 0u; mine = 0u;
#pragma unroll
        for (unsigned j = 0; j < 16; ++j) { const unsigned c = xb_ld(&bar[XB_XCNT(j)]); sum += c; cnt += (c > 0u) ? 1u : 0u; mine = (j == x) ? c : mine; }
        if (sum == G) break;
        __builtin_amdgcn_s_sleep(1);
        if ((++sp & 255u) == 0u) { if (xb_ld(&bar[XB_TMO])) break; if (sp > XB_SPIN_CAP) { atomicAdd(&bar[XB_TMO], 1u); break; } }
    }
    nloc = mine > 0u ? mine : 1u; nx = cnt > 0u ? cnt : 1u;
}

__device__ __forceinline__ void xcd_barrier(const XcdBarrier& b) {
    asm volatile("s_waitcnt vmcnt(0)" ::: "memory");
    __syncthreads();
    if (threadIdx.x == 0) {
        unsigned* bar = b.bar;
        __builtin_amdgcn_s_waitcnt(0);
        unsigned nloc = b.st[0], nx = b.st[1];
        if (nloc == 0u) { xcd_barrier_complete(bar, b.x, nloc, nx); b.st[0] = nloc; b.st[1] = nx; }
        const unsigned old = xb_add(&bar[XB_XSUB(b.x)], 1u);
        const unsigned gen = old / nloc;
        if (old + 1u == (gen + 1u) * nloc) {
            __builtin_amdgcn_fence(__ATOMIC_RELEASE, "agent");
            asm volatile("s_waitcnt vmcnt(0)" ::: "memory");
            const unsigned og = xb_add(&bar[XB_TOP], 1u);
            const unsigned tg = og / nx;
            if (og + 1u == (tg + 1u) * nx) xb_add(&bar[XB_TOPGEN], 1u);
            else XB_SPIN(xb_ld(&bar[XB_TOPGEN]) == tg, bar);
            __builtin_amdgcn_fence(__ATOMIC_ACQUIRE, "agent");
            xb_add(&bar[XB_XGEN(b.x)], 1u);
            asm volatile("s_waitcnt vmcnt(0)" ::: "memory");
        } else {
            XB_SPIN(xb_ld(&bar[XB_XGEN(b.x)]) == gen, bar);
            __builtin_amdgcn_fence(__ATOMIC_ACQUIRE, "agent");
            asm volatile("s_waitcnt vmcnt(0)" ::: "memory");
        }
    }
    __syncthreads();
}

struct Frame {
    LAS unsigned char* lds;
    volatile LAS unsigned* MISC;
    gu32* ctl;
    int tid, lane, wave, vcu, G;
    const float *xp, *xs, *cache_k, *cache_v, *state0; const int* ptab; const float *rel, *lbl;
    const float *n1, *wg1, *wu1, *wd1, *nmix, *win, *qn, *kn, *hn, *wout, *n2, *wg2, *wu2, *wd2;
    float* out;
    float *lb, *kmP, *kmS;
    bf16 *Wgu1, *Wd1, *Win, *Wout, *Wgu2, *Wd2, *XA, *MIX, *H;
    float *Dm, *X1, *X2, *REC, *Z, *GU;
};
__device__ __forceinline__ float wave_sum(float v) {
#pragma unroll
    for (int o = 1; o < 64; o <<= 1) v += __shfl_xor(v, o);
    return v;
}
__device__ __forceinline__ float wave_max(float v) {
#pragma unroll
    for (int o = 1; o < 64; o <<= 1) v = fmaxf(v, __shfl_xor(v, o));
    return v;
}
__device__ __forceinline__ float silu_f(float x) { return x / (1.f + expf(-x)); }
__device__ __forceinline__ float sigmoid_f(float x) { return 1.f / (1.f + expf(-x)); }
__device__ __forceinline__ void p0_transpose_item(const float* W, int K, int N, bf16* WT, int row_off, LAS float* scr, int item, int lane) {
    const int nblk = N / 32, kb = item / nblk, nb = item % nblk, k0 = 64 * kb, n0 = 32 * nb;
#pragma unroll 8
    for (int i = 0; i < 32; ++i) { const int kk = 2 * i + (lane >> 5); scr[kk * 33 + (lane & 31)] = W[(size_t)(k0 + kk) * N + n0 + (lane & 31)]; }
    LDS_WAIT(); asm volatile("" ::: "memory");
    const int c = lane & 7;
#pragma unroll
    for (int j = 0; j < 4; ++j) { const int n = (lane >> 3) + 8 * j; const LAS float* s = scr + (8 * c) * 33 + n;
        v4u o; o.x = pk2(s[0 * 33], s[1 * 33]); o.y = pk2(s[2 * 33], s[3 * 33]); o.z = pk2(s[4 * 33], s[5 * 33]); o.w = pk2(s[6 * 33], s[7 * 33]);
        *(GAS v4u*)(WT + (size_t)(row_off + n0 + n) * K + k0 + 8 * c) = o; }
    LDS_WAIT(); asm volatile("" ::: "memory");
}
__device__ __forceinline__ const float* xrow(const Frame& F, int r) { return r < MP ? F.xp + (size_t)r * D : F.xs + (size_t)(r - MP) * D; }
__device__ __forceinline__ void rms_store_bf16(int lane, const f32x4 (&v)[4], const float* gain, bf16* orow) {
    float s = 0.f;
#pragma unroll
    for (int j = 0; j < 4; ++j) s += (v[j].x * v[j].x + v[j].y * v[j].y) + (v[j].z * v[j].z + v[j].w * v[j].w);
    const float rs = 1.f / sqrtf(wave_sum(s) * (1.f / D) + EPS);
    GAS unsigned long long* o8 = (GAS unsigned long long*)orow + lane;
#pragma unroll
    for (int j = 0; j < 4; ++j) { const f32x4 g = ((const GAS f32x4*)gain)[lane + 64 * j];
        o8[64 * j] = (unsigned long long)pk2(v[j].x * rs * g.x, v[j].y * rs * g.y) | ((unsigned long long)pk2(v[j].z * rs * g.z, v[j].w * rs * g.w) << 32); }
}
__device__ __forceinline__ void zero_row_bf16(int lane, bf16* orow) {
    GAS unsigned long long* o8 = (GAS unsigned long long*)orow + lane;
#pragma unroll
    for (int j = 0; j < 4; ++j) o8[64 * j] = 0ull;
}
__device__ __forceinline__ void p0_prologue(Frame& F) {
    LAS float* scr = (LAS float*)(F.lds + RING_OFF + F.wave * 16384);
    const int gw = F.vcu * NWAVES + F.wave, NGW = F.G * NWAVES;
    constexpr int I_G = (D / 64) * (FF / 32), I_D = (FF / 64) * (D / 32), I_IN = (D / 64) * (NIN / 32), I_O = (D / 64) * (D / 32);
    constexpr int NITEMS = 4 * I_G + 2 * I_D + I_IN + I_O;
    for (int it = gw; it < NITEMS; it += NGW) {
        int r = it;
        if (r < I_G) { p0_transpose_item(F.wg1, D, FF, F.Wgu1, 0, scr, r, F.lane); continue; } r -= I_G;
        if (r < I_G) { p0_transpose_item(F.wu1, D, FF, F.Wgu1, FF, scr, r, F.lane); continue; } r -= I_G;
        if (r < I_G) { p0_transpose_item(F.wg2, D, FF, F.Wgu2, 0, scr, r, F.lane); continue; } r -= I_G;
        if (r < I_G) { p0_transpose_item(F.wu2, D, FF, F.Wgu2, FF, scr, r, F.lane); continue; } r -= I_G;
        if (r < I_D) { p0_transpose_item(F.wd1, FF, D, F.Wd1, 0, scr, r, F.lane); continue; } r -= I_D;
        if (r < I_D) { p0_transpose_item(F.wd2, FF, D, F.Wd2, 0, scr, r, F.lane); continue; } r -= I_D;
        if (r < I_IN) { p0_transpose_item(F.win, D, NIN, F.Win, 0, scr, r, F.lane); continue; } r -= I_IN;
        p0_transpose_item(F.wout, D, D, F.Wout, 0, scr, r, F.lane);
    }
    if (gw == 0) { for (int j = F.lane; j < 512; j += 64) F.lb[j] = sigmoid_f(F.lbl[j] - F.lbl[512 + j]); }
    for (int m = gw; m < M_ALL; m += NGW) {
        if (m < MR) { const GAS f32x4* xr = (const GAS f32x4*)xrow(F, m) + F.lane; f32x4 v[4];
#pragma unroll
            for (int j = 0; j < 4; ++j) v[j] = xr[64 * j];
            rms_store_bf16(F.lane, v, F.n1, F.XA + (size_t)m * D); }
        else zero_row_bf16(F.lane, F.XA + (size_t)m * D);
    }
    for (int it = F.vcu; it < SB * NBS; it += F.G) {
        const int sb = it / NBS, blk = it % NBS; float a = 0.f;
        for (int pg = 0; pg < 2; ++pg) { const int page = F.ptab[sb * NPG + blk * 2 + pg]; const float* base = F.cache_k + (size_t)page * PAGE * AW + F.tid;
#pragma unroll 8
            for (int s = 0; s < PAGE; ++s) a += base[(size_t)s * AW]; }
        F.kmS[(size_t)it * AW + F.tid] = a * (1.f / MOBA);
    }
}
__device__ __forceinline__ void ph_swiglu(Frame& F) {
    const int gw = F.vcu * NWAVES + F.wave, NGW = F.G * NWAVES;
    for (int m = gw; m < M_ALL; m += NGW) {
        const GAS f32x4* g4 = (const GAS f32x4*)(F.GU + (size_t)m * NGU); const GAS f32x4* u4 = (const GAS f32x4*)(F.GU + (size_t)m * NGU + FF);
        GAS unsigned long long* o8 = (GAS unsigned long long*)(F.H + (size_t)m * FF);
        for (int j = F.lane; j < FF / 4; j += 64) { const f32x4 g = g4[j], u = u4[j];
            o8[j] = (unsigned long long)pk2(silu_f(g.x) * u.x, silu_f(g.y) * u.y) | ((unsigned long long)pk2(silu_f(g.z) * u.z, silu_f(g.w) * u.w) << 32); }
    }
}
__device__ __forceinline__ void ph_resid_norm(Frame& F, int which, float sc, float* xo, const float* gain) {
    const int gw = F.vcu * NWAVES + F.wave, NGW = F.G * NWAVES;
    for (int m = gw; m < M_ALL; m += NGW) {
        if (m < MR) { const GAS f32x4* xr = (const GAS f32x4*)(which == 0 ? xrow(F, m) : F.X1 + (size_t)m * D) + F.lane; const GAS f32x4* dr = (const GAS f32x4*)(F.Dm + (size_t)m * D) + F.lane;
            GAS f32x4* o4 = (GAS f32x4*)(xo + (size_t)m * D) + F.lane; f32x4 v[4];
#pragma unroll
            for (int j = 0; j < 4; ++j) { v[j] = xr[64 * j] + dr[64 * j] * sc; o4[64 * j] = v[j]; }
            rms_store_bf16(F.lane, v, gain, F.XA + (size_t)m * D); }
        else zero_row_bf16(F.lane, F.XA + (size_t)m * D);
    }
}
__device__ __forceinline__ void ph_final(Frame& F) {
    const int gw = F.vcu * NWAVES + F.wave, NGW = F.G * NWAVES;
    for (int m = gw; m < MR; m += NGW) {
        const GAS f32x4* xr = (const GAS f32x4*)(F.X2 + (size_t)m * D) + F.lane; const GAS f32x4* dr = (const GAS f32x4*)(F.Dm + (size_t)m * D) + F.lane;
        GAS f32x4* o4 = (GAS f32x4*)(m < MP ? F.out + OFF_YP + (size_t)m * D : F.out + OFF_YS + (size_t)(m - MP) * D) + F.lane;
#pragma unroll
        for (int j = 0; j < 4; ++j) o4[64 * j] = xr[64 * j] + dr[64 * j] * 0.5f;
    }
}
__device__ __forceinline__ void ph_proj_rows(Frame& F) {
    const int gw = F.vcu * NWAVES + F.wave, NGW = F.G * NWAVES, lane = F.lane;
    const float qg = F.qn[lane], kg = F.kn[lane];
    for (int m = gw; m < MR; m += NGW) {
        float* z = F.Z + (size_t)m * NIN;
        float* ko = m < MP ? F.out + OFF_KP + (size_t)m * AW : F.out + OFF_KS + (size_t)(m - MP) * AW;
        float* vo = m < MP ? F.out + OFF_VP + (size_t)m * AW : F.out + OFF_VS + (size_t)(m - MP) * AW;
#pragma unroll
        for (int h = 0; h < AH; ++h) {
            const float q = z[ZQ + h * AD + lane], k = z[ZK + h * AD + lane], v = z[ZV + h * AD + lane];
            const float qs = wave_sum(q * q), ks = wave_sum(k * k);
            const float qn = q * (1.f / sqrtf(qs * (1.f / AD) + EPS)) * qg, kn = k * (1.f / sqrtf(ks * (1.f / AD) + EPS)) * kg;
            z[ZQ + h * AD + lane] = qn; z[ZK + h * AD + lane] = kn; ko[h * AD + lane] = kn; vo[h * AD + lane] = v;
        }
#pragma unroll
        for (int j = 0; j < 8; ++j) { const int c = j * 64 + lane; const float lbv = F.lb[c];
            z[ZQB + c] = silu_f(z[ZQB + c]); z[ZFB + c] = lbv + (1.f - lbv) * sigmoid_f(z[ZFB + c]); }
    }
}
__device__ __forceinline__ void ph_kmean_prompt(Frame& F) {
    for (int it = F.vcu; it < PB * NBP; it += F.G) {
        const float* base = F.Z + (size_t)(it * MOBA) * NIN + ZK + F.tid; float a = 0.f;
#pragma unroll 8
        for (int s = 0; s < MOBA; ++s) a += base[(size_t)s * NIN];
        F.kmP[(size_t)it * AW + F.tid] = a * (1.f / MOBA);
    }
}
__device__ __forceinline__ int rel_bucket(int n) { return n < 16 ? n : min(31, 39 - __clz(n * n)); }
template <bool SAMPLE>
__device__ __forceinline__ void moba_item(Frame& F, int item, LAS float* pl) {
    const int lane = F.lane;
    int b, h, t, qrow, qpos, n_full, own_start;
    if (!SAMPLE) { t = item % PT; h = (item / PT) % AH; b = item / (PT * AH); qrow = b * PT + t; qpos = t; n_full = t / MOBA; own_start = n_full * MOBA; }
    else { t = item % ST; h = (item / ST) % AH; b = item / (ST * AH); qrow = MP + b * ST + t; qpos = PAST + t; n_full = NBS; own_start = PAST; }
    const float* qp = F.Z + (size_t)qrow * NIN + ZQ + h * AD;
    f32x4 q4[16];
#pragma unroll
    for (int i = 0; i < 16; ++i) q4[i] = ((const f32x4*)qp)[i];
    float g = -INFINITY;
    if (lane < n_full) {
        const f32x4* km = (const f32x4*)((SAMPLE ? F.kmS + (size_t)(b * NBS + lane) * AW : F.kmP + (size_t)(b * NBP + lane) * AW) + h * AD);
        float a = 0.f;
#pragma unroll
        for (int i = 0; i < 16; ++i) { const f32x4 kv = km[i]; a += (q4[i].x * kv.x + q4[i].y * kv.y) + (q4[i].z * kv.z + q4[i].w * kv.w); }
        g = a;
    }
    int sel0 = 0, sel1 = 0, sel2 = 0;
#pragma unroll
    for (int j = 0; j < 3; ++j) {
        float bv = g; int bi = lane;
#pragma unroll
        for (int o = 32; o >= 1; o >>= 1) { const float ov = __shfl_xor(bv, o); const int oi = __shfl_xor(bi, o); if (ov > bv || (ov == bv && oi < bi)) { bv = ov; bi = oi; } }
        if (j == 0) sel0 = bi; else if (j == 1) sel1 = bi; else sel2 = bi;
        if (lane == bi) g = -INFINITY;
    }
    const int nsel = n_full < 3 ? n_full : 3;
    const int nown = qpos - own_start + 1;
    const int nkeys = nsel * MOBA + nown;
    float mx = -INFINITY;
    for (int g0 = 0; g0 < nkeys; g0 += 64) {
        const int kk = g0 + lane;
        if (kk < nkeys) {
            int kpos; const float* kp;
            if (kk < nsel * MOBA) { const int j = kk >> 8, o = kk & 255, blk = j == 0 ? sel0 : (j == 1 ? sel1 : sel2); kpos = blk * MOBA + o;
                if (!SAMPLE) kp = F.Z + (size_t)(b * PT + kpos) * NIN + ZK + h * AD;
                else { const int page = F.ptab[b * NPG + (kpos >> 7)]; kp = F.cache_k + ((size_t)(page * PAGE + (kpos & 127)) * AH + h) * AD; } }
            else { const int o = kk - nsel * MOBA; kpos = own_start + o;
                if (!SAMPLE) kp = F.Z + (size_t)(b * PT + kpos) * NIN + ZK + h * AD; else kp = F.Z + (size_t)(MP + b * ST + o) * NIN + ZK + h * AD; }
            float a = 0.f;
#pragma unroll
            for (int i = 0; i < 16; ++i) { const f32x4 kv = ((const f32x4*)kp)[i]; a += (q4[i].x * kv.x + q4[i].y * kv.y) + (q4[i].z * kv.z + q4[i].w * kv.w); }
            const float s = a * 0.125f + F.rel[rel_bucket(qpos - kpos) * AH + h];
            pl[kk] = s; mx = fmaxf(mx, s);
        }
    }
    mx = wave_max(mx);
    float sum = 0.f;
    for (int g0 = 0; g0 < nkeys; g0 += 64) { const int kk = g0 + lane; if (kk < nkeys) { const float p = expf(pl[kk] - mx); pl[kk] = p; sum += p; } }
    sum = wave_sum(sum);
    __builtin_amdgcn_wave_barrier(); LDS_WAIT();
    float acc = 0.f;
    for (int kk = 0; kk < nkeys; ++kk) {
        int kpos; const float* vp;
        if (kk < nsel * MOBA) { const int j = kk >> 8, o = kk & 255, blk = j == 0 ? sel0 : (j == 1 ? sel1 : sel2); kpos = blk * MOBA + o;
            if (!SAMPLE) vp = F.Z + (size_t)(b * PT + kpos) * NIN + ZV + h * AD;
            else { const int page = F.ptab[b * NPG + (kpos >> 7)]; vp = F.cache_v + ((size_t)(page * PAGE + (kpos & 127)) * AH + h) * AD; } }
        else { const int o = kk - nsel * MOBA; kpos = own_start + o;
            if (!SAMPLE) vp = F.Z + (size_t)(b * PT + kpos) * NIN + ZV + h * AD; else vp = F.Z + (size_t)(MP + b * ST + o) * NIN + ZV + h * AD; }
        acc += pl[kk] * vp[lane];
    }
    __builtin_amdgcn_wave_barrier(); LDS_WAIT();
    const float o = acc / sum;
    F.MIX[(size_t)qrow * D + h * AD + lane] = (bf16)f2bf(o);
}
template <bool SAMPLE>
__device__ __forceinline__ void hgrn_item(Frame& F, int item) {
    const int lane = F.lane, vi = lane >> 3, kc = lane & 7;
    const int vg = item % 16, h = (item / 16) % BH, seq = item / (16 * BH), v = vg * 8 + vi;
    const int T = SAMPLE ? ST : PT, row0 = SAMPLE ? MP + seq * ST : seq * PT;
    float S[16];
    float* sout = F.out + (SAMPLE ? OFF_SS : OFF_SP) + ((size_t)(seq * BH + h) * BKD + kc * 16) * BVD + v;
#pragma unroll
    for (int i = 0; i < 16; ++i) S[i] = SAMPLE ? F.state0[((size_t)(seq * BH + h) * BKD + kc * 16 + i) * BVD + v] : 0.f;
    for (int t = 0; t < T; ++t) {
        const float* z = F.Z + (size_t)(row0 + t) * NIN;
        const f32x4* q4 = (const f32x4*)(z + ZQB + h * BKD + kc * 16); const f32x4* f4 = (const f32x4*)(z + ZFB + h * BKD + kc * 16);
        const float vv = z[ZIB + h * BVD + v];
        float o = 0.f;
#pragma unroll
        for (int i = 0; i < 4; ++i) { const f32x4 q = q4[i], f = f4[i];
            S[4 * i + 0] = f.x * S[4 * i + 0] + (1.f - f.x) * vv; o += S[4 * i + 0] * q.x;
            S[4 * i + 1] = f.y * S[4 * i + 1] + (1.f - f.y) * vv; o += S[4 * i + 1] * q.y;
            S[4 * i + 2] = f.z * S[4 * i + 2] + (1.f - f.z) * vv; o += S[4 * i + 2] * q.z;
            S[4 * i + 3] = f.w * S[4 * i + 3] + (1.f - f.w) * vv; o += S[4 * i + 3] * q.w; }
        o += __shfl_xor(o, 1); o += __shfl_xor(o, 2); o += __shfl_xor(o, 4);
        if (kc == 0) F.REC[(size_t)(row0 + t) * BW + h * BVD + v] = o;
    }
#pragma unroll
    for (int i = 0; i < 16; ++i) sout[(size_t)i * BVD] = S[i];
}
__device__ __forceinline__ void ph_mixers(Frame& F) {
    const int gw = F.vcu * NWAVES + F.wave, NGW = F.G * NWAVES;
    LAS float* pl = (LAS float*)(F.lds + RING_OFF + F.wave * 8192);
    for (int it = F.vcu; it < PB * BH * 16; it += F.G) if (F.wave == 0) hgrn_item<false>(F, it);
    for (int it = gw; it < SB * BH * 16; it += NGW) hgrn_item<true>(F, it);
    for (int it = gw; it < SB * AH * ST; it += NGW) moba_item<true>(F, it, pl);
    for (int it = gw; it < PB * AH * PT; it += NGW) moba_item<false>(F, it, pl);
}
__device__ __forceinline__ void ph_rec_norm(Frame& F) {
    const int gw = F.vcu * NWAVES + F.wave, NGW = F.G * NWAVES, lane = F.lane;
    for (int m = gw; m < MR; m += NGW) {
        const float* r = F.REC + (size_t)m * BW; const float* gz = F.Z + (size_t)m * NIN + ZGB; bf16* o = F.MIX + (size_t)m * D + AW;
#pragma unroll
        for (int h = 0; h < BH; ++h) { const float a = r[h * BVD + lane], c = r[h * BVD + 64 + lane];
            const float rs = 1.f / sqrtf(wave_sum(a * a + c * c) * (1.f / BVD) + EPS);
            o[h * BVD + lane] = (bf16)f2bf(a * rs * F.hn[h * BVD + lane] * silu_f(gz[h * BVD + lane]));
            o[h * BVD + 64 + lane] = (bf16)f2bf(c * rs * F.hn[h * BVD + 64 + lane] * silu_f(gz[h * BVD + 64 + lane])); }
    }
    for (int m = MR + gw; m < M_ALL; m += NGW) zero_row_bf16(lane, F.MIX + (size_t)m * D);
}

constexpr int NPHASE = 16;
struct Args { const void* in[22]; float* out; unsigned char* ws; int ph_lo, ph_hi; };
__global__ void __launch_bounds__(NWAVES * 64, 2) mk_fwd(Args args) {
    extern __shared__ __attribute__((aligned(16))) unsigned char lds[];
    Frame F;
    F.lds = (LAS unsigned char*)lds;
    F.MISC = (volatile LAS unsigned*)(F.lds + MISC_OFF);
    F.tid = threadIdx.x; F.lane = F.tid & 63; F.wave = __builtin_amdgcn_readfirstlane(F.tid >> 6);
    F.G = gridDim.x; { const int bx = blockIdx.x; F.vcu = (F.G % 8 == 0) ? (bx % 8) * (F.G / 8) + bx / 8 : bx; }
    unsigned char* ws = args.ws;
    F.ctl = (gu32*)(ws + WS_CTL);
    F.xp = (const float*)args.in[0]; F.xs = (const float*)args.in[1]; F.cache_k = (const float*)args.in[2]; F.cache_v = (const float*)args.in[3]; F.state0 = (const float*)args.in[4];
    F.ptab = (const int*)args.in[5]; F.rel = (const float*)args.in[6]; F.lbl = (const float*)args.in[7];
    F.n1 = (const float*)args.in[8]; F.wg1 = (const float*)args.in[9]; F.wu1 = (const float*)args.in[10]; F.wd1 = (const float*)args.in[11];
    F.nmix = (const float*)args.in[12]; F.win = (const float*)args.in[13]; F.qn = (const float*)args.in[14]; F.kn = (const float*)args.in[15]; F.hn = (const float*)args.in[16];
    F.wout = (const float*)args.in[17]; F.n2 = (const float*)args.in[18]; F.wg2 = (const float*)args.in[19]; F.wu2 = (const float*)args.in[20]; F.wd2 = (const float*)args.in[21];
    F.out = args.out;
    F.lb = (float*)(ws + WS_SMALL); F.kmP = (float*)(ws + WS_SMALL + 4096); F.kmS = (float*)(ws + WS_KMS);
    F.Wgu1 = (bf16*)(ws + WS_WGU1); F.Wd1 = (bf16*)(ws + WS_WD1); F.Win = (bf16*)(ws + WS_WIN); F.Wout = (bf16*)(ws + WS_WOUT); F.Wgu2 = (bf16*)(ws + WS_WGU2); F.Wd2 = (bf16*)(ws + WS_WD2);
    F.XA = (bf16*)(ws + WS_XA); F.MIX = (bf16*)(ws + WS_MIX); F.H = (bf16*)(ws + WS_H);
    F.Dm = (float*)(ws + WS_D); F.X1 = (float*)(ws + WS_X1); F.X2 = (float*)(ws + WS_X2); F.REC = (float*)(ws + WS_REC); F.Z = (float*)(ws + WS_Z); F.GU = (float*)(ws + WS_GU);
    for (int u = F.tid; u < (LDS_BYTES - LDSCTL_OFF) / 4; u += NWAVES * 64) ((LAS unsigned*)(F.lds + LDSCTL_OFF))[u] = 0u;
    __syncthreads();
    const int lo = args.ph_lo, hi = args.ph_hi;
    XcdBarrier bar; bar.bar = (unsigned*)(F.ctl + CW_BAR); bar.x = 0; bar.st = nullptr;
    if (hi - lo > 1) bar = xcd_barrier_post((unsigned*)(F.ctl + CW_BAR), F.MISC + 8);
#define IN(k) (lo <= (k) && (k) < hi)
#define SEAM(k) do { if (IN(k) && IN((k) + 1)) xcd_barrier(bar); } while (0)
#define GEMM_F32(Abuf, Wbuf, Obuf, N_, K_) do { pg8::Gemm g{Abuf, Wbuf, M_ALL, N_, K_}; pg8::StaticOrder S; S.init(M_ALL, N_, F.G, (int)blockIdx.x); pg8::EpiF32 E{Obuf, N_}; \
        pg8::gemm_phase<pg8::EpiF32, pg8::StaticOrder, true, true>(F.lds + RING_OFF, g, S, E); } while (0)
    if (IN(0)) { p0_prologue(F); } SEAM(0);
    if (IN(1)) { GEMM_F32(F.XA, F.Wgu1, F.GU, NGU, D); } SEAM(1);
    if (IN(2)) { ph_swiglu(F); } SEAM(2);
    if (IN(3)) { GEMM_F32(F.H, F.Wd1, F.Dm, D, FF); } SEAM(3);
    if (IN(4)) { ph_resid_norm(F, 0, 0.5f, F.X1, F.nmix); } SEAM(4);
    if (IN(5)) { GEMM_F32(F.XA, F.Win, F.Z, NIN, D); } SEAM(5);
    if (IN(6)) { ph_proj_rows(F); } SEAM(6);
    if (IN(7)) { ph_kmean_prompt(F); } SEAM(7);
    if (IN(8)) { ph_mixers(F); } SEAM(8);
    if (IN(9)) { ph_rec_norm(F); } SEAM(9);
    if (IN(10)) { GEMM_F32(F.MIX, F.Wout, F.Dm, D, D); } SEAM(10);
    if (IN(11)) { ph_resid_norm(F, 1, 1.0f, F.X2, F.n2); } SEAM(11);
    if (IN(12)) { GEMM_F32(F.XA, F.Wgu2, F.GU, NGU, D); } SEAM(12);
    if (IN(13)) { ph_swiglu(F); } SEAM(13);
    if (IN(14)) { GEMM_F32(F.H, F.Wd2, F.Dm, D, FF); } SEAM(14);
    if (IN(15)) { ph_final(F); }
#undef IN
#undef SEAM
#undef GEMM_F32
}

#ifndef MK_N_LAUNCHES
#define MK_N_LAUNCHES 1
#endif
extern "C" void kernel_launch(void* const* d_in, const int* in_sizes, int n_in, void* d_out, int out_size, void* d_ws, size_t ws_size, hipStream_t stream) {
    static int grid = 0;
    if (grid == 0) {
        if (n_in != 22 || out_size != (int)OUT_TOTAL || ws_size < WS_END) { fprintf(stderr, "kernel_launch: unexpected shapes (n_in %d, out %d, ws %zu); nothing launched\n", n_in, out_size, ws_size); grid = -1; return; }
        int dev = 0, cus = 0;
        if (hipGetDevice(&dev) != hipSuccess || hipDeviceGetAttribute(&cus, hipDeviceAttributeMultiprocessorCount, dev) != hipSuccess) { grid = -1; return; }
        if (hipFuncSetAttribute((const void*)mk_fwd, hipFuncAttributeMaxDynamicSharedMemorySize, LDS_BYTES) != hipSuccess) { fprintf(stderr, "kernel_launch: hipFuncSetAttribute failed\n"); grid = -1; return; }
        (void)hipGetLastError();
        grid = cus;
    }
    if (grid < 0) return;
    if (hipMemsetAsync((char*)d_ws + WS_CTL, 0, CTL_ZERO_BYTES, stream) != hipSuccess) return;
    Args a{};
    for (int i = 0; i < 22; ++i) a.in[i] = d_in[i];
    a.out = (float*)d_out; a.ws = (unsigned char*)d_ws;
    if (MK_N_LAUNCHES == 1) { a.ph_lo = 0; a.ph_hi = NPHASE; hipLaunchKernelGGL(mk_fwd, dim3(grid), dim3(NWAVES * 64), LDS_BYTES, stream, a); }
    else for (int p = 0; p < NPHASE; ++p) { a.ph_lo = p; a.ph_hi = p + 1; hipLaunchKernelGGL(mk_fwd, dim3(grid), dim3(NWAVES * 64), LDS_BYTES, stream, a); }
}
```

```cpp
#include <hip/hip_runtime.h>
#include <cstdio>
#include <cstdint>
namespace pg8 {
#define PG8_LAS __attribute__((address_space(3)))
typedef unsigned short bf16_t;
typedef short bf16x8 __attribute__((ext_vector_type(8)));
typedef float f32x4 __attribute__((ext_vector_type(4)));
typedef unsigned u32x4 __attribute__((ext_vector_type(4)));
constexpr int BM = 256, BK = 64, HALF = 128, HTB = HALF * BK * 2  , STAGE_BYTES = 8 * HTB, NXCD = 8, WGM = 8;

__host__ __device__ __forceinline__ int lds_byte(int r, int c) { const int st = (r >> 4) * 2 + (c >> 5), rr = r & 15, cc = c & 31, ob = rr * 64 + cc * 2; return st * 1024 + (ob ^ (((ob >> 9) & 1) << 5)); }
__host__ __device__ __forceinline__ void stage_rc(int b, int& R, int& C) { const int st = b / 1024, sb = b % 1024, swz = sb ^ (((sb >> 9) & 1) << 5); R = (st >> 1) * 16 + swz / 64; C = (st & 1) * 32 + (swz % 64) / 2; }
__host__ __device__ __forceinline__ int perm32(int rho) { const int n = rho >> 4, i = rho & 15; return 8 * (i >> 2) + 4 * n + (i & 3); }

struct Unit { int pm, pn; };
struct Gemm { const bf16_t* A; const bf16_t* Bt; int M, N, K; };

struct StaticOrder {
    int nM, nN, nwg, G, c;
    __host__ __device__ void init(int M, int N, int G_, int c_) { nM = M / BM; nN = N / BM; nwg = nM * nN; G = G_; c = c_; }
    __host__ __device__ bool next(int i, Unit& u) const {
        const long L = (long)i * G + c; if (L >= nwg) return false;
        int wgid = (int)L; { const int q = nwg / NXCD, r = nwg % NXCD, xcd = wgid % NXCD, off = wgid / NXCD; wgid = (xcd < r ? xcd * (q + 1) : r * (q + 1) + (xcd - r) * q) + off; }
        const int nig = WGM * nN, gid = wgid / nig, fm = gid * WGM, gsz = (nM - fm) < WGM ? (nM - fm) : WGM;
        u.pm = fm + ((wgid % nig) % gsz); u.pn = (wgid % nig) / gsz; return true;
    }
    __device__ __forceinline__ void a_ready(const Unit&) const {}
    __device__ __forceinline__ void done(const Unit&) const {}
};

__device__ __forceinline__ unsigned cvt_pk_bf16(float lo, float hi) { unsigned r; asm volatile("v_cvt_pk_bf16_f32 %0, %1, %2" : "=v"(r) : "v"(lo), "v"(hi)); return r; }
typedef float f32x2 __attribute__((ext_vector_type(2)));
constexpr int SS_STRIDE = 16640;
struct RowRs {
    const float* ss; int np; const PG8_LAS float* tab; int mp;
    __device__ __forceinline__ float get(int row) const {
        if (tab && row >= mp) return tab[row - mp];
        float s;
        if (np == 16) { const f32x4* p4 = (const f32x4*)(ss + (size_t)row * 16); const f32x4 a = p4[0], b = p4[1], c = p4[2], d = p4[3]; s = ((a[0] + a[1]) + (a[2] + a[3])) + ((b[0] + b[1]) + (b[2] + b[3])) + (((c[0] + c[1]) + (c[2] + c[3])) + ((d[0] + d[1]) + (d[2] + d[3]))); }
        else s = ss[row];
        return 1.f / sqrtf(s * (1.f / 1024.f) + 1e-6f); }
};
__device__ __forceinline__ float silu_fast(float x) { return x * __builtin_amdgcn_rcpf(1.f + __expf(-x)); }
struct EpiSwiglu {
    static constexpr bool PERM = true, AFTER_DRAIN = false;
    bf16_t* H; int ldh; RowRs R;
    __device__ __forceinline__ void operator()(const f32x4 (&acc)[2][2][4][2], const Unit& u, int wr, int wc, int fr, int fq) const {
        const int row0 = u.pm * BM + wr * 64 + fr, hcol = u.pn * HALF + wc * 32 + 8 * fq;
#pragma unroll
        for (int ai = 0; ai < 2; ++ai)
#pragma unroll
            for (int m = 0; m < 4; ++m) { const int row = row0 + ai * HALF + m * 16; const float rs = R.get(row);
                const f32x4 g0 = acc[ai][0][m][0] * rs, g1 = acc[ai][0][m][1] * rs, u0 = acc[ai][1][m][0] * rs, u1 = acc[ai][1][m][1] * rs;
                u32x4 w; w.x = cvt_pk_bf16(silu_fast(g0[0]) * u0[0], silu_fast(g0[1]) * u0[1]); w.y = cvt_pk_bf16(silu_fast(g0[2]) * u0[2], silu_fast(g0[3]) * u0[3]);
                w.z = cvt_pk_bf16(silu_fast(g1[0]) * u1[0], silu_fast(g1[1]) * u1[1]); w.w = cvt_pk_bf16(silu_fast(g1[2]) * u1[2], silu_fast(g1[3]) * u1[3]);
                *(u32x4*)(H + (size_t)row * ldh + hcol) = w; }
    }
};
struct EpiF32Rs {
    static constexpr bool PERM = true, AFTER_DRAIN = false;
    float* O; int ldc; RowRs R;
    __device__ __forceinline__ void operator()(const f32x4 (&acc)[2][2][4][2], const Unit& u, int wr, int wc, int fr, int fq) const {
        const int row0 = u.pm * BM + wr * 64 + fr, col0 = u.pn * BM + wc * 64 + 8 * fq;
#pragma unroll
        for (int ai = 0; ai < 2; ++ai)
#pragma unroll
            for (int m = 0; m < 4; ++m) { const int row = row0 + ai * HALF + m * 16; const float rs = R.get(row); float* rowp = O + (size_t)row * ldc + col0;
#pragma unroll
                for (int bj = 0; bj < 2; ++bj) { *(f32x4*)(rowp + 32 * bj) = acc[ai][bj][m][0] * rs; *(f32x4*)(rowp + 32 * bj + 4) = acc[ai][bj][m][1] * rs; } }
    }
};
template <bool BB>
struct EpiResid {
    static constexpr bool PERM = true, AFTER_DRAIN = false;
    const void* bp; float* op; bf16_t* xa; float* sso; float sc;
    __device__ __forceinline__ void operator()(const f32x4 (&acc)[2][2][4][2], const Unit& u, int wr, int wc, int fr, int fq) const {
        const int row0 = u.pm * BM + wr * 64 + fr, col0 = u.pn * BM + wc * 64 + 8 * fq;
#pragma unroll
        for (int ai = 0; ai < 2; ++ai) {
            f32x4 bv[4][2][2];
#pragma unroll
            for (int m = 0; m < 4; ++m) { const size_t off = (size_t)(row0 + ai * HALF + m * 16) * 1024 + col0;
#pragma unroll
                for (int bj = 0; bj < 2; ++bj) {
                    if (BB) { const u32x4 w = *(const u32x4*)((const bf16_t*)bp + off + 32 * bj);
                        bv[m][bj][0] = (f32x4){__uint_as_float(w.x << 16), __uint_as_float(w.x & 0xffff0000u), __uint_as_float(w.y << 16), __uint_as_float(w.y & 0xffff0000u)};
                        bv[m][bj][1] = (f32x4){__uint_as_float(w.z << 16), __uint_as_float(w.z & 0xffff0000u), __uint_as_float(w.w << 16), __uint_as_float(w.w & 0xffff0000u)}; }
                    else { const float* b = (const float*)bp + off + 32 * bj; bv[m][bj][0] = *(const f32x4*)b; bv[m][bj][1] = *(const f32x4*)(b + 4); } } }
#pragma unroll
            for (int m = 0; m < 4; ++m) { const int row = row0 + ai * HALF + m * 16; const size_t off = (size_t)row * 1024 + col0; float ssq = 0.f;
#pragma unroll
                for (int bj = 0; bj < 2; ++bj) {
                    const f32x4 v0 = bv[m][bj][0] + acc[ai][bj][m][0] * sc, v1 = bv[m][bj][1] + acc[ai][bj][m][1] * sc;
                    if (op) { *(f32x4*)(op + off + 32 * bj) = v0; *(f32x4*)(op + off + 32 * bj + 4) = v1; }
                    ssq += (v0[0] * v0[0] + v0[1] * v0[1]) + (v0[2] * v0[2] + v0[3] * v0[3]) + (v1[0] * v1[0] + v1[1] * v1[1]) + (v1[2] * v1[2] + v1[3] * v1[3]);
                    if (xa) { u32x4 w; w.x = cvt_pk_bf16(v0[0], v0[1]); w.y = cvt_pk_bf16(v0[2], v0[3]); w.z = cvt_pk_bf16(v1[0], v1[1]); w.w = cvt_pk_bf16(v1[2], v1[3]); *(u32x4*)(xa + off + 32 * bj) = w; } }
                ssq += __shfl_xor(ssq, 16); ssq += __shfl_xor(ssq, 32);
                if (sso && fq == 0) sso[(size_t)row * 16 + 4 * u.pn + wc] = ssq; }
        }
    }
};
struct EpiProj {
    static constexpr bool PERM = true, AFTER_DRAIN = false;
    RowRs R; const float *qg, *kg, *lb;
    bf16_t *QB, *KB, *VB; float* QS;
    float *kp, *ks, *vp, *vs;
    float* kmP;
    bf16_t *HQ; float* HF; bf16_t *HV, *HG;
    int mp, mr; float c2;
    __device__ __forceinline__ void st8(float* p, const f32x4& a, const f32x4& b) const { *(f32x4*)p = a; *(f32x4*)(p + 4) = b; }
    __device__ __forceinline__ void st8b(bf16_t* p, const f32x4& a, const f32x4& b, float s) const { u32x4 w; w.x = cvt_pk_bf16(a[0] * s, a[1] * s); w.y = cvt_pk_bf16(a[2] * s, a[3] * s); w.z = cvt_pk_bf16(b[0] * s, b[1] * s); w.w = cvt_pk_bf16(b[2] * s, b[3] * s); *(u32x4*)p = w; }
    __device__ __forceinline__ void operator()(const f32x4 (&acc)[2][2][4][2], const Unit& u, int wr, int wc, int fr, int fq) const {
        const int type = u.pn >> 1, cb = 256 * (u.pn & 1) + 64 * wc, row0 = u.pm * BM + wr * 64 + fr, d0 = 8 * fq;
        f32x4 gn[2][2], cs[2][2];
#pragma unroll
        for (int bj = 0; bj < 2; ++bj)
#pragma unroll
            for (int n = 0; n < 2; ++n) { cs[bj][n] = (f32x4){0.f, 0.f, 0.f, 0.f}; gn[bj][n] = (f32x4){1.f, 1.f, 1.f, 1.f};
                if (type <= 1) gn[bj][n] = *(const f32x4*)((type == 0 ? qg : kg) + 32 * bj + d0 + 4 * n);
                if (type == 4) gn[bj][n] = *(const f32x4*)(lb + cb + 32 * bj + d0 + 4 * n); }
#pragma unroll
        for (int ai = 0; ai < 2; ++ai)
#pragma unroll
            for (int m = 0; m < 4; ++m) { const int row = row0 + ai * HALF + m * 16;
                if (row < mr) {
                    const float rs = R.get(row); f32x4 v[2][2];
#pragma unroll
                    for (int bj = 0; bj < 2; ++bj)
#pragma unroll
                        for (int n = 0; n < 2; ++n) v[bj][n] = acc[ai][bj][m][n] * rs;
                    const size_t o = (size_t)row * 512 + cb + d0, os = (size_t)(row - mp) * 512 + cb + d0;
                    if (type <= 1) {
                        float ss = 0.f;
#pragma unroll
                        for (int bj = 0; bj < 2; ++bj)
#pragma unroll
                            for (int n = 0; n < 2; ++n) ss += (v[bj][n][0] * v[bj][n][0] + v[bj][n][1] * v[bj][n][1]) + (v[bj][n][2] * v[bj][n][2] + v[bj][n][3] * v[bj][n][3]);
                        ss += __shfl_xor(ss, 16); ss += __shfl_xor(ss, 32);
                        const float rn = 1.f / sqrtf(ss * (1.f / 64.f) + 1e-6f);
#pragma unroll
                        for (int bj = 0; bj < 2; ++bj)
#pragma unroll
                            for (int n = 0; n < 2; ++n) v[bj][n] = v[bj][n] * rn * gn[bj][n];
                    }
                    if (type == 0) {
                        if (row < mp) { st8b(QB + o, v[0][0], v[0][1], c2); st8b(QB + o + 32, v[1][0], v[1][1], c2); } else { st8(QS + os, v[0][0], v[0][1]); st8(QS + os + 32, v[1][0], v[1][1]); }
                    } else if (type == 1) {
                        if (row < mp) { st8(kp + o, v[0][0], v[0][1]); st8(kp + o + 32, v[1][0], v[1][1]); st8b(KB + o, v[0][0], v[0][1], 1.f); st8b(KB + o + 32, v[1][0], v[1][1], 1.f);
                            cs[0][0] += v[0][0]; cs[0][1] += v[0][1]; cs[1][0] += v[1][0]; cs[1][1] += v[1][1]; }
                        else { st8(ks + os, v[0][0], v[0][1]); st8(ks + os + 32, v[1][0], v[1][1]); }
                    } else if (type == 2) {
                        if (row < mp) { st8(vp + o, v[0][0], v[0][1]); st8(vp + o + 32, v[1][0], v[1][1]); st8b(VB + o, v[0][0], v[0][1], 1.f); st8b(VB + o + 32, v[1][0], v[1][1], 1.f); }
                        else { st8(vs + os, v[0][0], v[0][1]); st8(vs + os + 32, v[1][0], v[1][1]); }
                    } else if (type == 5) { st8b(HV + o, v[0][0], v[0][1], 1.f); st8b(HV + o + 32, v[1][0], v[1][1], 1.f);
                    } else {
#pragma unroll
                        for (int bj = 0; bj < 2; ++bj)
#pragma unroll
                            for (int n = 0; n < 2; ++n)
#pragma unroll
                                for (int j = 0; j < 4; ++j) { const float z = v[bj][n][j];
                                    if (type == 4) { const float lbv = gn[bj][n][j]; v[bj][n][j] = __logf(lbv + (1.f - lbv) * __builtin_amdgcn_rcpf(1.f + __expf(-z))); } else v[bj][n][j] = silu_fast(z); }
                        if (type == 4) { st8(HF + o, v[0][0], v[0][1]); st8(HF + o + 32, v[1][0], v[1][1]); }
                        else { bf16_t* dst = (type == 3 ? HQ : HG) + o; st8b(dst, v[0][0], v[0][1], 1.f); st8b(dst + 32, v[1][0], v[1][1], 1.f); }
                    }
                } }
        if (type == 1 && u.pm * BM < mp) {
#pragma unroll
            for (int bj = 0; bj < 2; ++bj)
#pragma unroll
                for (int n = 0; n < 2; ++n)
#pragma unroll
                    for (int j = 0; j < 4; ++j) { float s = cs[bj][n][j]; s += __shfl_xor(s, 1); s += __shfl_xor(s, 2); s += __shfl_xor(s, 4); s += __shfl_xor(s, 8);
                        if (fr == 0) __hip_atomic_fetch_add(kmP + (size_t)u.pm * 512 + cb + 32 * bj + d0 + 4 * n + j, s * (1.f / 256.f), __ATOMIC_RELAXED, __HIP_MEMORY_SCOPE_AGENT); }
        }
    }
};
__device__ __forceinline__ void pg8_mfma_tied(f32x4& c, const bf16x8& a, const bf16x8& b) { asm volatile("v_mfma_f32_16x16x32_bf16 %0, %1, %2, %0" : "+v"(c) : "v"(a), "v"(b)); }
template <class Epi, class Sched, bool ALIGN_EPI = false, bool SP2 = false>
__device__ __forceinline__ void gemm_phase(PG8_LAS unsigned char* lds, const Gemm g, const Sched& S, const Epi& E) {
    const int tid = threadIdx.x, wid = __builtin_amdgcn_readfirstlane(tid >> 6), lane = tid & 63, wr = wid >> 2, wc = wid & 3, fr = lane & 15, fq = lane >> 4;
    const int K = g.K, nt = K / BK;
    unsigned voffA[2], voffB[2];
#pragma unroll
    for (int i = 0; i < 2; ++i) { int R, C; stage_rc(tid * 16 + i * 8192, R, C); const int Rb = Epi::PERM ? ((R & ~31) + perm32(R & 31)) : R;
        voffA[i] = (unsigned)(R * K + C) * 2u; voffB[i] = (unsigned)(Rb * K + C) * 2u; }
    const size_t kstep = (size_t)(BK * 2);
    const size_t hstep = (size_t)HALF * K * 2;
    const size_t tstep = 2 * hstep;
    const unsigned ldsw = (unsigned)wid * 1024u;
    const int aoff = lds_byte(wr * 64 + fr, fq * 8), boff = lds_byte(wc * 32 + fr, fq * 8);
#define PG8_SA(b, h) (((b) * 2 + (h)) * HTB)
#define PG8_SB(b, h) ((4 + (b) * 2 + (h)) * HTB)
#define PG8_STAGE(bufoff, gbase, voff) do { _Pragma("unroll") for (int _i = 0; _i < 2; ++_i) \
        __builtin_amdgcn_global_load_lds((const unsigned*)((const char*)(gbase) + (voff)[_i]), (PG8_LAS unsigned*)(lds + (bufoff) + ldsw + _i * 8192), 16, 0, 0); } while (0)
#define PG8_LDA(dst, b, h) do { _Pragma("unroll") for (int m = 0; m < 4; ++m) _Pragma("unroll") for (int k = 0; k < 2; ++k) dst[m][k] = *(const PG8_LAS bf16x8*)(lds + PG8_SA(b, h) + aoff + m * 2048 + k * 1024); } while (0)
#define PG8_LDB(dst, b, h) do { _Pragma("unroll") for (int n = 0; n < 2; ++n) _Pragma("unroll") for (int k = 0; k < 2; ++k) dst[n][k] = *(const PG8_LAS bf16x8*)(lds + PG8_SB(b, h) + boff + n * 2048 + k * 1024); } while (0)
#define PG8_MMA(ai, bj, At, Bt) do { __builtin_amdgcn_s_setprio(1); _Pragma("unroll") for (int m = 0; m < 4; ++m) _Pragma("unroll") for (int n = 0; n < 2; ++n) _Pragma("unroll") for (int k = 0; k < 2; ++k) \
        pg8_mfma_tied(acc[ai][bj][m][n], Bt[n][k], At[m][k]); __builtin_amdgcn_s_setprio(0); } while (0)
#define PG8_WAIT_V(n) asm volatile("s_waitcnt vmcnt(" #n ")" ::: "memory")
#define PG8_WAIT_L(n) asm volatile("s_waitcnt lgkmcnt(" #n ")" ::: "memory")
#define PG8_BAR __builtin_amdgcn_s_barrier()
#define PG8_SCHED __builtin_amdgcn_sched_barrier(0)
    Unit cur, nxt; int ui = 0;
    if (!S.next(0, cur)) return;
    f32x4 acc[2][2][4][2];
#pragma unroll
    for (int a = 0; a < 2; ++a)
#pragma unroll
        for (int b = 0; b < 2; ++b)
#pragma unroll
            for (int m = 0; m < 4; ++m)
#pragma unroll
                for (int n = 0; n < 2; ++n) acc[a][b][m][n] = (f32x4){0.f, 0.f, 0.f, 0.f};
    bf16x8 At[4][2], B0[2][2], B1[2][2];
    const char* cA = (const char*)g.A + (size_t)cur.pm * tstep; const char* cB = (const char*)g.Bt + (size_t)cur.pn * tstep;
    S.a_ready(cur);
    if constexpr (SP2) {
        PG8_STAGE(PG8_SB(0, 0), cB, voffB); PG8_STAGE(PG8_SB(0, 1), cB + hstep, voffB); PG8_STAGE(PG8_SA(0, 0), cA, voffA); PG8_STAGE(PG8_SA(0, 1), cA + hstep, voffA);
        if (wr == 1) PG8_BAR;
        PG8_WAIT_V(2); PG8_BAR;
        PG8_STAGE(PG8_SB(1, 0), cB + kstep, voffB); PG8_STAGE(PG8_SA(1, 0), cA + kstep, voffA); PG8_STAGE(PG8_SB(1, 1), cB + hstep + kstep, voffB);
        PG8_WAIT_V(6); PG8_BAR;
    } else {
        PG8_STAGE(PG8_SB(0, 0), cB, voffB); PG8_STAGE(PG8_SA(0, 0), cA, voffA); PG8_STAGE(PG8_SB(0, 1), cB + hstep, voffB); PG8_STAGE(PG8_SA(0, 1), cA + hstep, voffA);
        if (wr == 1) PG8_BAR;
        PG8_WAIT_V(4); PG8_BAR;
        PG8_STAGE(PG8_SB(1, 0), cB + kstep, voffB); PG8_STAGE(PG8_SA(1, 0), cA + kstep, voffA); PG8_STAGE(PG8_SB(1, 1), cB + hstep + kstep, voffB);
        PG8_WAIT_V(6); PG8_BAR;
    }
    for (;;) {
        const bool has_next = S.next(ui + 1, nxt);
        const char* nA = has_next ? (const char*)g.A + (size_t)nxt.pm * tstep : cA; const char* nB = has_next ? (const char*)g.Bt + (size_t)nxt.pn * tstep : cB;
        for (int t = 0; t < nt; t += 2) {
            const bool last = (t == nt - 2);
            const char* a1 = cA + (size_t)(t + 1) * kstep;
            const char* a2 = last ? nA : cA + (size_t)(t + 2) * kstep; const char* b2 = last ? nB : cB + (size_t)(t + 2) * kstep;
            const char* a3 = a2 + kstep; const char* b3 = b2 + kstep;
            if (last && has_next) S.a_ready(nxt);
            if constexpr (SP2) {
            PG8_LDB(B0, 0, 0); PG8_LDB(B1, 0, 1); PG8_SCHED; PG8_LDA(At, 0, 0); PG8_STAGE(PG8_SA(1, 1), a1 + hstep, voffA);
            PG8_WAIT_V(8); PG8_WAIT_L(0); PG8_BAR; PG8_MMA(0, 0, At, B0); PG8_MMA(0, 1, At, B1); PG8_BAR; PG8_SCHED;
            PG8_LDA(At, 0, 1); PG8_STAGE(PG8_SB(0, 0), b2, voffB); PG8_STAGE(PG8_SB(0, 1), b2 + hstep, voffB); PG8_STAGE(PG8_SA(0, 0), a2, voffA);
            PG8_WAIT_V(8); PG8_WAIT_L(0); PG8_BAR; PG8_MMA(1, 0, At, B0); PG8_MMA(1, 1, At, B1); PG8_BAR; PG8_SCHED;
            PG8_LDB(B0, 1, 0); PG8_LDB(B1, 1, 1); PG8_SCHED; PG8_LDA(At, 1, 0); PG8_STAGE(PG8_SA(0, 1), a2 + hstep, voffA);
            PG8_WAIT_V(8); PG8_WAIT_L(0); PG8_BAR; PG8_MMA(0, 0, At, B0); PG8_MMA(0, 1, At, B1); PG8_BAR; PG8_SCHED;
            PG8_LDA(At, 1, 1); PG8_STAGE(PG8_SB(1, 0), b3, voffB); PG8_STAGE(PG8_SB(1, 1), b3 + hstep, voffB); PG8_STAGE(PG8_SA(1, 0), a3, voffA);
            PG8_WAIT_V(8); PG8_WAIT_L(0); PG8_BAR; PG8_MMA(1, 0, At, B0); PG8_MMA(1, 1, At, B1); PG8_BAR; PG8_SCHED;
            } else {
            PG8_LDB(B0, 0, 0); PG8_SCHED; PG8_LDA(At, 0, 0); PG8_STAGE(PG8_SA(1, 1), a1 + hstep, voffA);
            PG8_WAIT_L(8); PG8_BAR; PG8_WAIT_L(0); PG8_MMA(0, 0, At, B0); PG8_BAR; PG8_SCHED;
            PG8_LDB(B1, 0, 1); PG8_STAGE(PG8_SB(0, 0), b2, voffB);
            PG8_BAR; PG8_WAIT_L(0); PG8_MMA(0, 1, At, B1); PG8_BAR;
            PG8_LDA(At, 0, 1); PG8_STAGE(PG8_SA(0, 0), a2, voffA);
            PG8_BAR; PG8_WAIT_L(0); PG8_MMA(1, 0, At, B0); PG8_BAR; PG8_SCHED;
            PG8_STAGE(PG8_SB(0, 1), b2 + hstep, voffB);
            PG8_WAIT_V(6); PG8_BAR; PG8_MMA(1, 1, At, B1); PG8_BAR;
            PG8_LDB(B0, 1, 0); PG8_SCHED; PG8_LDA(At, 1, 0); PG8_STAGE(PG8_SA(0, 1), a2 + hstep, voffA);
            PG8_WAIT_L(8); PG8_BAR; PG8_WAIT_L(0); PG8_MMA(0, 0, At, B0); PG8_BAR; PG8_SCHED;
            PG8_LDB(B1, 1, 1); PG8_STAGE(PG8_SB(1, 0), b3, voffB);
            PG8_BAR; PG8_WAIT_L(0); PG8_MMA(0, 1, At, B1); PG8_BAR;
            PG8_LDA(At, 1, 1); PG8_STAGE(PG8_SA(1, 0), a3, voffA);
            PG8_BAR; PG8_WAIT_L(0); PG8_MMA(1, 0, At, B0); PG8_BAR; PG8_SCHED;
            PG8_STAGE(PG8_SB(1, 1), b3 + hstep, voffB);
            PG8_WAIT_V(6); PG8_BAR; PG8_MMA(1, 1, At, B1); PG8_BAR;
            }
        }
        if constexpr (ALIGN_EPI) { if (wr == 0) PG8_BAR; }
        asm volatile("s_nop 15\n\ts_nop 15" ::: "memory");
        if constexpr (!Epi::AFTER_DRAIN) { E(acc, cur, wr, wc, fr, fq); S.done(cur); }
        if (!has_next) break;
#pragma unroll
        for (int a = 0; a < 2; ++a)
#pragma unroll
            for (int b = 0; b < 2; ++b)
#pragma unroll
                for (int m = 0; m < 4; ++m)
#pragma unroll
                    for (int n = 0; n < 2; ++n) acc[a][b][m][n] = (f32x4){0.f, 0.f, 0.f, 0.f};
        cur = nxt; cA = nA; cB = nB; ++ui;
        if constexpr (ALIGN_EPI) { if (wr == 1) PG8_BAR; }
    }
    PG8_WAIT_V(0);
    if constexpr (!ALIGN_EPI) { if (wr == 0) PG8_BAR; }
    PG8_BAR;
    if constexpr (Epi::AFTER_DRAIN) { E.fused(acc, cur, wr, wc, fr, fq, lds, wid, lane); S.done(cur); }
#undef PG8_SA
#undef PG8_SB
#undef PG8_STAGE
#undef PG8_LDA
#undef PG8_LDB
#undef PG8_MMA
#undef PG8_WAIT_V
#undef PG8_WAIT_L
#undef PG8_BAR
#undef PG8_SCHED
}
}
constexpr int NWAVES = 8;
constexpr int D = 1024, FF = 2816, NGU = 2 * FF, NIN = 3584;
constexpr int PB = 4, PT = 4096, MP = PB * PT;
constexpr int SB = 32, ST = 4, MS = SB * ST;
constexpr int MR = MP + MS;
constexpr int M_ALL = 16640;
constexpr int AH = 8, AD = 64, AW = 512;
constexpr int BH = 4, BKD = 128, BVD = 128, BW = 512;
constexpr int PAST = 8192, PAGE = 128, NPG = 64, MOBA = 256, NBS = PAST / MOBA  , NBP = PT / MOBA  ;
constexpr float EPS = 1e-6f;
constexpr int ZQ = 0, ZK = 512, ZV = 1024, ZQB = 1536, ZFB = 2048, ZIB = 2560, ZGB = 3072;
constexpr size_t OFF_YP = 0, OFF_YS = 16777216, OFF_KP = 16908288, OFF_VP = 25296896, OFF_SP = 33685504, OFF_KS = 33947648, OFF_VS = 34013184, OFF_SS = 34078720, OUT_TOTAL = 36175872;
constexpr size_t MiB = 1u << 20;
constexpr size_t WS_CTL = 0, CTL_ZERO_BYTES = 1 * MiB;
constexpr size_t WS_SMALL = 1 * MiB;
constexpr size_t WS_KMS = 2 * MiB;
constexpr size_t WS_WGU1 = 4 * MiB, WS_WD1 = 15 * MiB, WS_WIN = 21 * MiB, WS_WOUT = 28 * MiB, WS_WGU2 = 30 * MiB, WS_WD2 = 41 * MiB;
constexpr size_t WS_XA = 48 * MiB, WS_MIX = 81 * MiB, WS_H = 114 * MiB, WS_D = 204 * MiB, WS_X1 = 270 * MiB, WS_X2 = 336 * MiB, WS_REC = 402 * MiB, WS_Z = 436 * MiB, WS_GU = 664 * MiB, WS_QB = 1024 * MiB, WS_KB = 1040 * MiB, WS_VB = 1056 * MiB, WS_HL = 1072 * MiB, WS_HD = 1088 * MiB, WS_HQ = 1090 * MiB, WS_HF = 1124 * MiB, WS_QS = 1158 * MiB, WS_XA2 = 1160 * MiB, WS_XA3 = 1194 * MiB, WS_D2 = 1228 * MiB, WS_D3 = 1294 * MiB, WS_H2 = 1360 * MiB, WS_GU2 = 1452 * MiB, WS_SS0 = 1812 * MiB, WS_SS1 = 1814 * MiB, WS_SS2 = 1816 * MiB, WS_HV = 1818 * MiB, WS_HG = 1852 * MiB, WS_PO = 1886 * MiB, WS_PM = 1934 * MiB, WS_PL = 1936 * MiB, WS_LST = 1938 * MiB, WS_CNT = 1946 * MiB, WS_TABG = 1947 * MiB, WS_END = 1948 * MiB;
static_assert(WS_WD2 + (size_t)D * FF * 2 <= WS_XA && WS_XA + (size_t)M_ALL * D * 2 <= WS_MIX && WS_MIX + (size_t)M_ALL * D * 2 <= WS_H && WS_H + (size_t)M_ALL * FF * 2 <= WS_D &&
              WS_D + (size_t)M_ALL * D * 4 <= WS_X1 && WS_X1 + (size_t)M_ALL * D * 4 <= WS_X2 && WS_X2 + (size_t)M_ALL * D * 4 <= WS_REC && WS_REC + (size_t)M_ALL * BW * 4 <= WS_Z &&
              WS_Z + (size_t)M_ALL * NIN * 4 <= WS_GU && WS_GU + (size_t)M_ALL * NGU * 4 <= WS_QB && WS_QB + (size_t)MP * AW * 2 <= WS_KB && WS_VB + (size_t)MP * AW * 2 <= WS_END, "d_ws map");
constexpr int CW_TMO = 0, CW_CODE = 1, CW_BAR = 4096;
constexpr int RING_OFF = 0, RING_BYTES = 131072, LDSCTL_OFF = RING_BYTES, MISC_OFF = LDSCTL_OFF + 320, LDS_BYTES = 147456;
static_assert(MISC_OFF + 128 <= LDS_BYTES, "LDS map");
#include <hip/hip_bf16.h>
#include <cmath>
namespace moba {
using bf16h=__hip_bfloat16;
using bf16x8=__attribute__((ext_vector_type(8)))short;
using s16x4=__attribute__((ext_vector_type(4)))short;
using f32x16=__attribute__((ext_vector_type(16)))float;
using u32x4=__attribute__((ext_vector_type(4)))unsigned;
constexpr int BATCH=4,NHEAD=8,SEQ=4096,D=64;
constexpr int QP=512,KP=512,VP=512,OP=1024;
constexpr int NW=8,QBLK=32,QB=QBLK*NW,KVBLK=64,NQB=SEQ/QB;
__device__ __forceinline__ int crow(int r,int hi){return (r&3)+8*(r>>2)+4*hi;}
#define SBAR() __builtin_amdgcn_sched_barrier(0)
#define MLAS __attribute__((address_space(3)))
__device__ __forceinline__ void cmask(f32x16&p0,f32x16&p1,int lim){
  const float NEG=-INFINITY;
  #pragma unroll
  for(int r=0;r<16;++r){const int c=(r&3)+8*(r>>2); if(c>lim)p0[r]=NEG; if(c+32>lim)p1[r]=NEG;}
}
constexpr int NSLOT=3, NSLOTA=4, SLOTB=8192;
constexpr int LDS_K=0, LDS_V=NSLOTA*SLOTB, LDS_WS=2*NSLOTA*SLOTB, LDS_TAB=LDS_WS+NW*64*4, TAB_N=4096, LDS_OST=LDS_TAB+TAB_N*4, LDS_BYTES=LDS_OST+NW*4096;
constexpr float LOG2E=1.4426950408889634f;
constexpr float C2=0.125f*LOG2E;
__device__ __forceinline__ void glds16(const void*gsrc,unsigned lds_dst){unsigned keep;
  asm volatile("s_mov_b32 %0, m0\n\ts_mov_b32 m0, %2\n\ts_nop 0\n\tglobal_load_lds_dwordx4 %1, off\n\ts_mov_b32 m0, %0":"=&s"(keep):"v"(gsrc),"s"(lds_dst):"memory");}
__device__ __forceinline__ float max3f(float a,float b,float c){float r;asm("v_max3_f32 %0, %1, %2, %3":"=v"(r):"v"(a),"v"(b),"v"(c));return r;}
__device__ __forceinline__ float max2f(float a,float b){float r;asm("v_max_f32_e32 %0, %1, %2":"=v"(r):"v"(a),"v"(b));return r;}
__device__ __forceinline__ float fadd_s(float a,float b){float r;asm("v_add_f32_e32 %0, %1, %2":"=v"(r):"v"(a),"v"(b));return r;}
__device__ __forceinline__ float fsub_s(float a,float b){float r;asm("v_sub_f32_e32 %0, %1, %2":"=v"(r):"v"(a),"v"(b));return r;}
typedef float f32x2_t __attribute__((ext_vector_type(2))); typedef float f32x4_t __attribute__((ext_vector_type(4))); typedef __bf16 bf16x2_t __attribute__((ext_vector_type(2)));
__device__ __forceinline__ unsigned cvtpk_s(float lo,float hi){f32x2_t v={lo,hi};bf16x2_t b=__builtin_convertvector(v,bf16x2_t);return __builtin_bit_cast(unsigned,b);}
#define WAIT_BAR(N) asm volatile("s_waitcnt vmcnt(" #N ") lgkmcnt(0)\n\ts_barrier":::"memory")
typedef MLAS const char* lds_cptr;
typedef short v4i16_t __attribute__((ext_vector_type(4)));
__device__ __forceinline__ void qkt(f32x16&p0,f32x16&p1,const char*Kslot,const bf16x8*qr,int r32,int hi){
  const char*kb=Kslot+hi*1024+r32*16;
  #pragma unroll
  for(int d0=0;d0<4;++d0){
    const bf16x8 b0=*reinterpret_cast<const bf16x8*>(kb+d0*2048);
    const bf16x8 b1=*reinterpret_cast<const bf16x8*>(kb+d0*2048+512);
    p0=__builtin_amdgcn_mfma_f32_32x32x16_bf16(b0,qr[d0],p0,0,0,0);p1=__builtin_amdgcn_mfma_f32_32x32x16_bf16(b1,qr[d0],p1,0,0,0);}
}
__device__ __forceinline__ void kload8(bf16x8*kf,lds_cptr kp){
  kf[0]=*(const MLAS bf16x8*)(kp);      kf[1]=*(const MLAS bf16x8*)(kp+512);
  kf[2]=*(const MLAS bf16x8*)(kp+2048); kf[3]=*(const MLAS bf16x8*)(kp+2560);
  kf[4]=*(const MLAS bf16x8*)(kp+4096); kf[5]=*(const MLAS bf16x8*)(kp+4608);
  kf[6]=*(const MLAS bf16x8*)(kp+6144); kf[7]=*(const MLAS bf16x8*)(kp+6656);
}
__device__ __forceinline__ void kload2(bf16x8*kf,lds_cptr kp,int j){ kf[2*j]=*(const MLAS bf16x8*)(kp+j*2048); kf[2*j+1]=*(const MLAS bf16x8*)(kp+j*2048+512); }
__device__ __forceinline__ s16x4 vtr(lds_cptr p){ return __builtin_bit_cast(s16x4,__builtin_amdgcn_ds_read_tr16_b64_v4i16((MLAS v4i16_t*)p)); }
__device__ __forceinline__ float rowmax(const f32x16&p0,const f32x16&p1){
  float a=max3f(p0[0],p0[1],p1[0]),b=max3f(p0[2],p0[3],p1[1]);a=max3f(a,p1[2],p1[3]);
  #pragma unroll
  for(int r=4;r<16;r+=4){a=max3f(a,p0[r],p0[r+1]);b=max3f(b,p0[r+2],p0[r+3]);a=max3f(a,p1[r],p1[r+1]);b=max3f(b,p1[r+2],p1[r+3]);}
  const float m=max2f(a,b);
  auto rr=__builtin_amdgcn_permlane32_swap(__float_as_uint(m),__float_as_uint(m),false,false);
  return max2f(__uint_as_float(rr[0]),__uint_as_float(rr[1]));
}
__device__ __forceinline__ void pv(f32x16*o,int vb,bf16x8 pa0,bf16x8 pa1,bf16x8 pa2,bf16x8 pa3){
  #pragma unroll
  for(int d0=0;d0<2;++d0){s16x4 lo[4],hi[4];
    #pragma unroll
    for(int ks=0;ks<4;++ks){
      asm volatile("ds_read_b64_tr_b16 %0,%1 offset:%c2":"=&v"(lo[ks]):"v"(vb),"i"(d0*4096+ks*1024):"memory");
      asm volatile("ds_read_b64_tr_b16 %0,%1 offset:%c2":"=&v"(hi[ks]):"v"(vb),"i"(d0*4096+ks*1024+512):"memory");}
    asm volatile("s_waitcnt lgkmcnt(0)":::"memory");SBAR();
    #define PK(k) (bf16x8){lo[k][0],lo[k][1],lo[k][2],lo[k][3],hi[k][0],hi[k][1],hi[k][2],hi[k][3]}
    o[d0]=__builtin_amdgcn_mfma_f32_32x32x16_bf16(pa0,PK(0),o[d0],0,0,0);
    o[d0]=__builtin_amdgcn_mfma_f32_32x32x16_bf16(pa1,PK(1),o[d0],0,0,0);
    o[d0]=__builtin_amdgcn_mfma_f32_32x32x16_bf16(pa2,PK(2),o[d0],0,0,0);
    o[d0]=__builtin_amdgcn_mfma_f32_32x32x16_bf16(pa3,PK(3),o[d0],0,0,0);
    #undef PK
  }
}
#ifndef ATTN_STORE16
#define ATTN_STORE16(p,v) (*(u32x4*)(p)=(v))
#endif
template<int THRL,bool GATHER> __device__ __forceinline__ void moba_core(int b,int h,int qb,int gq,int grec,const bf16h*Q,const bf16h*__restrict__ K,const bf16h*__restrict__ V,bf16h*O,bf16h*PO,float*PM,float*PL,char*shm){
  int tid_=threadIdx.x; asm volatile("":"+v"(tid_));
  const int tid=tid_,lane=tid&63,r32=lane&31,hi=lane>>5; const int wid=__builtin_amdgcn_readfirstlane(tid>>6);
  const long rowbase=(long)b*SEQ; const int q0=qb*QB;
  const bf16h*Qw=Q+(rowbase+q0+wid*QBLK)*QP+h*D;
  const bf16h*Kh=K+rowbase*KP+h*D,*Vh=V+rowbase*VP+h*D;
  const unsigned lds0=(unsigned)(uintptr_t)shm;
  float*wsf=(float*)(shm+LDS_WS)+wid*64;
  const bf16h*ksrc=Kh+(long)lane*KP+wid*8;
  const bf16h*vsrc=Vh+(long)(16*(wid&3)+(lane>>2))*VP+(wid>>2)*32+(lane&3)*8;
  const unsigned kdst=lds0+LDS_K+wid*1024, vdst=lds0+LDS_V+wid*1024;
  #define KVROW(t) (((t)<4)?(q0+64*(t)):(64*((t)-4)))
  #define DMA_K(t,slot) glds16(ksrc+(long)KVROW(t)*KP,(unsigned)__builtin_amdgcn_readfirstlane(kdst+(slot)))
  #define DMA_V(t,slot) glds16(vsrc+(long)KVROW(t)*VP,(unsigned)__builtin_amdgcn_readfirstlane(vdst+(slot)))
  const int vb0=(int)(lds0+LDS_V)+((lane>>4)&1)*32+(lane&3)*8+(4*hi+((lane&15)>>2))*64;
  const char*Kbase=shm+LDS_K; bf16x8 kf[8];
  const lds_cptr shm3=(lds_cptr)shm; const lds_cptr kp0=shm3+LDS_K+hi*1024+r32*16; const lds_cptr vp0=shm3+LDS_V+((lane>>4)&1)*32+(lane&3)*8+(4*hi+((lane&15)>>2))*64;
  const lds_cptr tabr0=shm3+LDS_TAB+4*(TAB_N-1)+16*hi;
  constexpr int T0=GATHER?4:0;
  const int qrel=wid*QBLK+r32;
  const int qoff=GATHER?(gq-256*qb):(q0+qrel);
  if(!GATHER){DMA_K(0,0);DMA_V(0,0);DMA_K(1,SLOTB);}
  bf16x8 qr[4];
  { const bf16h*Qg=GATHER?(Q+(rowbase+gq)*QP+h*D):(Qw+(long)r32*QP);
  #pragma unroll
  for(int d0=0;d0<4;++d0)qr[d0]=*reinterpret_cast<const bf16x8*>(&Qg[d0*16+hi*8]); }
  float mhat=0.f,l_reg=0.f;f32x16 o[2];o[0]=f32x16{};o[1]=f32x16{};
  #define CR(r) (((r)&3)+8*((r)>>2))
  #define BIASLD(C0,C1,t) do{ const int tt_=(t); const int db_=(tt_<4)?(qrel-64*tt_):(qoff-64*(tt_-4)); const lds_cptr tb_=tabr0-4*db_;   \
      _Pragma("unroll") for(int r=0;r<16;++r){ C0[r]=*(const MLAS float*)(tb_+4*CR(r)); C1[r]=*(const MLAS float*)(tb_+4*(CR(r)+32)); } }while(0)
  #define CADD(C0,C1,t) do{ const float x_=-mhat; \
      _Pragma("unroll") for(int r=0;r<16;++r){ C0[r]+=x_; C1[r]+=x_; } }while(0)
  #define CINIT(C0,C1,t) do{ BIASLD(C0,C1,t); CADD(C0,C1,t); }while(0)
  #define CMASK(P0,P1,t) do{ if((t)<4)cmask(P0,P1,qrel-64*(t)-4*hi); }while(0)
  bool resc=false;
  #define START(P0,P1) do{ const float rm=rowmax(P0,P1); resc=false; \
    { const float dl=rm; mhat=fadd_s(mhat,dl); \
      _Pragma("unroll") for(int r=0;r<16;++r){P0[r]=fsub_s(P0[r],dl);P1[r]=fsub_s(P1[r],dl);} } \
    _Pragma("unroll") for(int r=0;r<16;++r)P0[r]=__builtin_amdgcn_exp2f(P0[r]); }while(0)
  #define RESC() do{ if(resc){ asm volatile("s_waitcnt lgkmcnt(0)":::"memory"); \
      _Pragma("unroll") for(int d_=0;d_<2;++d_) _Pragma("unroll") for(int r=0;r<16;++r)o[d_][r]*=wsf[crow(r,hi)]; } }while(0)
  f32x16 pA0,pA1,pB0,pB1;
  int sl_prev=0,sl_cur=0,sl_next=SLOTB;
  #define ROT() do{sl_prev=sl_cur;sl_cur=sl_next;sl_next=(sl_next==((GATHER?NSLOTA:NSLOT)-1)*SLOTB)?0:sl_next+SLOTB;}while(0)
  if(!GATHER){DMA_K(2,2*SLOTB);}
  if(!GATHER){WAIT_BAR(3);}
  CINIT(pA0,pA1,T0);
  qkt(pA0,pA1,Kbase,qr,r32,hi);asm volatile("s_nop 15\n\ts_nop 7":"+v"(pA0),"+v"(pA1));CMASK(pA0,pA1,T0);
  START(pA0,pA1);
  _Pragma("unroll") for(int r=0;r<16;++r)pA1[r]=__builtin_amdgcn_exp2f(pA1[r]);
  if(!GATHER){WAIT_BAR(0);DMA_K(3,0);DMA_V(1,SLOTB);}
  ROT();
  kload8(kf,kp0+sl_cur);
  if(!GATHER){WAIT_BAR(2);}
  s16x4 vlo[8],vhi[8]; u32x4 pw0,pw1,pw2,pw3;
  #define PKW(P,B) cvtpk_s(P[B],P[B+1])
  #define PAF(k) __builtin_bit_cast(bf16x8,pw##k)
  #define VFR(i) (bf16x8){vlo[i][0],vlo[i][1],vlo[i][2],vlo[i][3],vhi[i][0],vhi[i][1],vhi[i][2],vhi[i][3]}
  #define PIN(x) asm volatile("":"+v"(x))
  #define MX3(a,b,c) __builtin_fmaxf(__builtin_fmaxf((a),(b)),(c))
  #define GAPA(MF,A0,A1,A2,A3,W0,W1,PW) do{ MF; sacc+=A0; sacc+=A1; sacc+=A2; sacc+=A3; PIN(sacc); W0; W1; PIN(PW); SBAR(); }while(0)
  #define EX(v) __builtin_amdgcn_exp2f(v)
  #define GAPB(MF,X,B) do{ MF; X[B]=EX(X[B]); X[B+1]=EX(X[B+1]); X[B+2]=EX(X[B+2]); X[B+3]=EX(X[B+3]); PIN(X); SBAR(); }while(0)
  #define VRD(i) do{ vlo[i]=vtr(vp_+(((i)>>2)*4096+((i)&3)*1024)); vhi[i]=vtr(vp_+(((i)>>2)*4096+((i)&3)*1024+512)); }while(0)
  #define KRD(G,j) do{ if(G){ kload2(kf,kp0+sl_next,j); SBAR(); } }while(0)
  #define STEP(C0,C1,P0,P1,t,GK,GV,GL) do{ SBAR(); \
    CADD(C0,C1,t); SBAR(); \
    const lds_cptr vp_=vp0+sl_prev; \
    VRD(0); SBAR(); float sacc=(P0[0]+P0[1]); \
    GAPA(C0=__builtin_amdgcn_mfma_f32_32x32x16_bf16(kf[0],qr[0],C0,0,0,0), P0[2],P0[3],P0[4],P0[5],     pw0[0]=PKW(P0,0), pw0[1]=PKW(P0,2), pw0); \
    VRD(4); SBAR(); GAPA(C1=__builtin_amdgcn_mfma_f32_32x32x16_bf16(kf[1],qr[0],C1,0,0,0), P0[6],P0[7],P0[8],P0[9],     pw0[2]=PKW(P0,4), pw0[3]=PKW(P0,6), pw0); \
    VRD(1); SBAR(); GAPA(C0=__builtin_amdgcn_mfma_f32_32x32x16_bf16(kf[2],qr[1],C0,0,0,0),   P0[10],P0[11],P0[12],P0[13], pw1[0]=PKW(P0,8), pw1[1]=PKW(P0,10), pw1); \
    VRD(5); SBAR(); GAPA(C1=__builtin_amdgcn_mfma_f32_32x32x16_bf16(kf[3],qr[1],C1,0,0,0),   P0[14],P0[15],P1[0],P1[1],   pw1[2]=PKW(P0,12),pw1[3]=PKW(P0,14), pw1); \
    VRD(2); SBAR(); GAPA(C0=__builtin_amdgcn_mfma_f32_32x32x16_bf16(kf[4],qr[2],C0,0,0,0),   P1[2],P1[3],P1[4],P1[5],     pw2[0]=PKW(P1,0), pw2[1]=PKW(P1,2), pw2); \
    VRD(6); SBAR(); GAPA(C1=__builtin_amdgcn_mfma_f32_32x32x16_bf16(kf[5],qr[2],C1,0,0,0),   P1[6],P1[7],P1[8],P1[9],     pw2[2]=PKW(P1,4), pw2[3]=PKW(P1,6), pw2); \
    VRD(3); SBAR(); GAPA(C0=__builtin_amdgcn_mfma_f32_32x32x16_bf16(kf[6],qr[3],C0,0,0,0),   P1[10],P1[11],P1[12],P1[13], pw3[0]=PKW(P1,8), pw3[1]=PKW(P1,10), pw3); \
    VRD(7); SBAR(); GAPA(C1=__builtin_amdgcn_mfma_f32_32x32x16_bf16(kf[7],qr[3],C1,0,0,0),   P1[14],P1[15],0.f,0.f,       pw3[2]=PKW(P1,12),pw3[3]=PKW(P1,14), pw3); \
    l_reg+=sacc; \
    if(GK){DMA_K((t)+3,sl_cur);} if(GV){DMA_V((t)+1,sl_next);} \
    CMASK(C0,C1,t); \
    { float a=MX3(C0[0],C0[1],C1[0]),b=MX3(C0[2],C0[3],C1[1]); a=MX3(a,C1[2],C1[3]); \
      _Pragma("unroll") for(int r=4;r<16;r+=4){a=MX3(a,C0[r],C0[r+1]);b=MX3(b,C0[r+2],C0[r+3]);a=MX3(a,C1[r],C1[r+1]);b=MX3(b,C1[r+2],C1[r+3]);} \
      float rm=__builtin_fmaxf(a,b); { auto rr=__builtin_amdgcn_permlane32_swap(__float_as_uint(rm),__float_as_uint(rm),false,false); rm=__builtin_fmaxf(__uint_as_float(rr[0]),__uint_as_float(rr[1])); } \
      resc=false; \
      if(__builtin_expect(__any(rm>(float)THRL),0)){ const float dl=__builtin_fmaxf(rm,0.f); mhat+=dl; \
        _Pragma("unroll") for(int r=0;r<16;++r){C0[r]-=dl;C1[r]-=dl;} \
        const float f=__builtin_amdgcn_exp2f(-dl); l_reg*=f; if(hi==0)wsf[r32]=f; resc=true; } } \
    SBAR(); \
    if(GL){ BIASLD(P0,P1,(t)+1); } SBAR(); \
    GAPB(o[0]=__builtin_amdgcn_mfma_f32_32x32x16_bf16(PAF(0),VFR(0),o[0],0,0,0), C0,0); \
    GAPB(o[1]=__builtin_amdgcn_mfma_f32_32x32x16_bf16(PAF(0),VFR(4),o[1],0,0,0), C0,4); \
    KRD(GL,0); GAPB(o[0]=__builtin_amdgcn_mfma_f32_32x32x16_bf16(PAF(1),VFR(1),o[0],0,0,0), C0,8); \
    KRD(GL,1); GAPB(o[1]=__builtin_amdgcn_mfma_f32_32x32x16_bf16(PAF(1),VFR(5),o[1],0,0,0), C0,12); \
    KRD(GL,2); GAPB(o[0]=__builtin_amdgcn_mfma_f32_32x32x16_bf16(PAF(2),VFR(2),o[0],0,0,0), C1,0); \
    KRD(GL,3); GAPB(o[1]=__builtin_amdgcn_mfma_f32_32x32x16_bf16(PAF(2),VFR(6),o[1],0,0,0), C1,4); \
    GAPB(o[0]=__builtin_amdgcn_mfma_f32_32x32x16_bf16(PAF(3),VFR(3),o[0],0,0,0), C1,8); \
    GAPB(o[1]=__builtin_amdgcn_mfma_f32_32x32x16_bf16(PAF(3),VFR(7),o[1],0,0,0), C1,12); \
    }while(0)
  BIASLD(pB0,pB1,T0+1);
  if(GATHER){
    STEP(pB0,pB1,pA0,pA1,5,false,false,true);  RESC(); ROT();
    STEP(pA0,pA1,pB0,pB1,6,false,false,true);  RESC(); ROT();
    STEP(pB0,pB1,pA0,pA1,7,false,false,false); RESC();
  }else{
    STEP(pB0,pB1,pA0,pA1,1,false,true,true);   WAIT_BAR(1); RESC(); ROT();
    STEP(pA0,pA1,pB0,pB1,2,false,true,true);   WAIT_BAR(0); RESC(); ROT();
    STEP(pB0,pB1,pA0,pA1,3,false,false,false); RESC();
  }
  { float sacc=pB0[0]+pB0[1]; _Pragma("unroll") for(int r=2;r<16;++r)sacc+=pB0[r]; _Pragma("unroll") for(int r=0;r<16;++r)sacc+=pB1[r]; l_reg+=sacc;
    pw0=(u32x4){PKW(pB0,0),PKW(pB0,2),PKW(pB0,4),PKW(pB0,6)};pw1=(u32x4){PKW(pB0,8),PKW(pB0,10),PKW(pB0,12),PKW(pB0,14)};pw2=(u32x4){PKW(pB1,0),PKW(pB1,2),PKW(pB1,4),PKW(pB1,6)};pw3=(u32x4){PKW(pB1,8),PKW(pB1,10),PKW(pB1,12),PKW(pB1,14)};
    SBAR(); pv(o,vb0+sl_cur,PAF(0),PAF(1),PAF(2),PAF(3)); }
  #undef PKW
  #undef PAF
  #undef VFR
  #undef PIN
  #undef MX3
  #undef GAPA
  #undef GAPB
  #undef EX
  #undef VRD
  #undef KRD
  #undef STEP
  {auto rr=__builtin_amdgcn_permlane32_swap(__float_as_uint(l_reg),__float_as_uint(l_reg),false,false);l_reg=__uint_as_float(rr[0])+__uint_as_float(rr[1]);}
  bf16h*stg=(bf16h*)(shm+LDS_OST)+wid*2048;
  if(GATHER){
    int*wsi=(int*)wsf;
    if(hi==0){ wsi[r32]=grec; if(grec>=0){PM[grec]=mhat;PL[grec]=l_reg;} }
    #pragma unroll
    for(int r=0;r<16;++r){const int orow=crow(r,hi);
      #pragma unroll
      for(int d0=0;d0<2;++d0)stg[orow*64+d0*32+r32]=__float2bfloat16(o[d0][r]);}
    asm volatile("s_waitcnt lgkmcnt(0)":::"memory");
    #pragma unroll
    for(int i=0;i<4;++i){const int row=i*8+(lane>>3),ch=lane&7; const u32x4 v=*(const u32x4*)(stg+row*64+ch*8); const int rc=wsi[row]; if(rc>=0)ATTN_STORE16(PO+(size_t)rc*64+ch*8,v);}
    asm volatile("s_waitcnt lgkmcnt(0)":::"memory");
  }else{
    const int ns=qb<3?qb:3;
    const size_t rb0=((size_t)((b*NHEAD+h)*3)*SEQ)+(size_t)(q0+wid*QBLK);
    float pm[3],pl[3]; u32x4 prow[3][4];
    #pragma unroll
    for(int s_=0;s_<3;++s_) if(s_<ns){ const size_t rb=rb0+(size_t)s_*SEQ; pm[s_]=PM[rb+r32]; pl[s_]=PL[rb+r32];
      #pragma unroll
      for(int i=0;i<4;++i)prow[s_][i]=*(const u32x4*)(PO+(rb+(size_t)(i*8+(lane>>3)))*64+(lane&7)*8); }
    float mm=mhat;
    #pragma unroll
    for(int s_=0;s_<3;++s_) if(s_<ns)mm=__builtin_fmaxf(mm,pm[s_]);
    const float fo=__builtin_amdgcn_exp2f(mhat-mm); float lt=l_reg*fo; float fs[3];
    #pragma unroll
    for(int s_=0;s_<3;++s_) if(s_<ns){ fs[s_]=__builtin_amdgcn_exp2f(pm[s_]-mm); lt+=pl[s_]*fs[s_]; }
    if(hi==0){wsf[r32]=fo;wsf[32+r32]=lt;}
    asm volatile("s_waitcnt lgkmcnt(0)":::"memory");
    #pragma unroll
    for(int r=0;r<16;++r){ const float f_=wsf[crow(r,hi)]; o[0][r]*=f_; o[1][r]*=f_; }
    #pragma unroll
    for(int s_=0;s_<3;++s_) if(s_<ns){
      asm volatile("s_waitcnt lgkmcnt(0)":::"memory");
      if(hi==0)wsf[r32]=fs[s_];
      #pragma unroll
      for(int i=0;i<4;++i){const int row=i*8+(lane>>3),ch=lane&7; *(u32x4*)(stg+row*64+ch*8)=prow[s_][i];}
      asm volatile("s_waitcnt lgkmcnt(0)":::"memory");
      #pragma unroll
      for(int r=0;r<16;++r){const int orow=crow(r,hi); const float f_=wsf[orow];
        #pragma unroll
        for(int d0=0;d0<2;++d0)o[d0][r]+=f_*__bfloat162float(stg[orow*64+d0*32+r32]);}
    }
    asm volatile("s_waitcnt lgkmcnt(0)":::"memory");
    float rli[16];
    #pragma unroll
    for(int r=0;r<16;++r)rli[r]=__builtin_amdgcn_rcpf(wsf[32+crow(r,hi)]);
    bf16h*Ow=O+(rowbase+q0+wid*QBLK)*OP+h*D;
    #pragma unroll
    for(int r=0;r<16;++r){const int orow=crow(r,hi);
      #pragma unroll
      for(int d0=0;d0<2;++d0)stg[orow*64+d0*32+r32]=__float2bfloat16(o[d0][r]*rli[r]);}
    asm volatile("s_waitcnt lgkmcnt(0)":::"memory");
    #pragma unroll
    for(int i=0;i<4;++i){const int row=i*8+(lane>>3),ch=lane&7; const u32x4 v=*(const u32x4*)(stg+row*64+ch*8); ATTN_STORE16(Ow+(long)row*OP+ch*8,v);}
    asm volatile("s_waitcnt lgkmcnt(0)\n\ts_barrier":::"memory");
  }
  #undef DMA_K
  #undef DMA_V
  #undef KVROW
  #undef CMASK
  #undef CINIT
  #undef BIASLD
  #undef CADD
  #undef CR
  #undef START
  #undef RESC
  #undef ROT
}
constexpr int ATTN_LDS_BYTES=LDS_BYTES;
#undef SBAR
#undef WAIT_BAR
}
namespace hg {
typedef short s16x4 __attribute__((ext_vector_type(4)));
typedef short s16x8 __attribute__((ext_vector_type(8)));
typedef float f32x4 __attribute__((ext_vector_type(4)));
#define HLAS __attribute__((address_space(3)))
constexpr int ROWB = 136, IMG = 128 * ROWB, OFF_QT = 0, OFF_KT = IMG, OFF_VT = 2 * IMG, OFF_DCH = 3 * IMG, BUFB = 3 * IMG + 2048, OFF_TOT = 2 * BUFB, OFF_SSQ = 2 * BUFB + 2048, OFF_OW = OFF_SSQ + 4096, LDS_BYTES = OFF_OW + 8 * 2048;
constexpr int SC = 256, NSC = 16;
__device__ __forceinline__ unsigned pkbf(float lo, float hi) { typedef float f2 __attribute__((ext_vector_type(2))); typedef __bf16 b2 __attribute__((ext_vector_type(2))); f2 v = {lo, hi}; b2 b = __builtin_convertvector(v, b2); return __builtin_bit_cast(unsigned, b); }
__device__ __forceinline__ void mfma32_t(f32x4& c, const s16x8& a, const s16x8& b) { asm volatile("s_nop 1\n\tv_mfma_f32_16x16x32_bf16 %0, %1, %2, %0" : "+v"(c) : "v"(a), "v"(b)); }
__device__ __forceinline__ void mfma16_t(f32x4& c, const s16x4& a, const s16x4& b) { asm volatile("s_nop 1\n\tv_mfma_f32_16x16x16_bf16 %0, %1, %2, %0" : "+v"(c) : "v"(a), "v"(b)); }
template <int CTRL> __device__ __forceinline__ float dpp_f(float v) { return __builtin_bit_cast(float, __builtin_amdgcn_update_dpp(0, __builtin_bit_cast(int, v), CTRL, 0xf, 0xf, true)); }
__device__ __forceinline__ float row16_sum(float s) { s += dpp_f<0x128>(s); s += dpp_f<0x124>(s); s += dpp_f<0x122>(s); s += dpp_f<0x121>(s); return s; }
__device__ __forceinline__ s16x4 trr(const HLAS char* p) { return __builtin_bit_cast(s16x4, __builtin_amdgcn_ds_read_tr16_b64_v4i16((HLAS s16x4*)p)); }
template <bool FULL>
__device__ __forceinline__ void hgrn_unit(int b, int h, int n, const unsigned short* __restrict__ Qs, int qpitch, const float* __restrict__ Fs, int fpitch, const unsigned short* __restrict__ Vs, int vpitch, const unsigned short* __restrict__ Gs, const float* __restrict__ gain, unsigned short* __restrict__ MIXo, float* __restrict__ slabL, float* __restrict__ slabD,
                                          float* __restrict__ state_out, HLAS char* lds) {
    const int tid = threadIdx.x, lane = tid & 63, x = lane & 15, g = lane >> 4; const int w = __builtin_amdgcn_readfirstlane(tid >> 6);
    const int unit = (b * 4 + h) * NSC + n; const size_t row0 = (size_t)b * 4096 + (size_t)n * SC;
    const int pk = tid & 127, pcg = tid >> 7;
    float lf[16]; unsigned vvp[8], qqp[8];
#define HG_LOADRAW(gq) do { const size_t r0_ = row0 + 64 * (gq) + 16 * pcg; const unsigned short* qr_ = Qs + r0_ * qpitch + h * 128 + pk; const float* fr_ = Fs + r0_ * fpitch + h * 128 + pk; const unsigned short* vr_ = Vs + r0_ * vpitch + h * 128 + pk; \
        _Pragma("unroll") for (int j = 0; j < 16; ++j) lf[j] = fr_[(size_t)j * fpitch]; \
        _Pragma("unroll") for (int j = 0; j < 16; j += 2) { vvp[j >> 1] = (unsigned)vr_[(size_t)j * vpitch] | ((unsigned)vr_[(size_t)(j + 1) * vpitch] << 16); if (FULL) qqp[j >> 1] = (unsigned)qr_[(size_t)j * qpitch] | ((unsigned)qr_[(size_t)(j + 1) * qpitch] << 16); } } while (0)
    f32x4 S[8];
#pragma unroll
    for (int kt = 0; kt < 8; ++kt) S[kt] = (f32x4){0.f, 0.f, 0.f, 0.f};
    if (FULL) {
        typedef unsigned u32x2 __attribute__((ext_vector_type(2)));
        HLAS f32x4* dt = (HLAS f32x4*)(lds + OFF_OW);
        for (int i = tid; i < n * 32; i += 512) dt[i] = ((const f32x4*)(slabD + (size_t)((b * 4 + h) * NSC) * 128))[i];
        __syncthreads();
        const u32x2* Lb = (const u32x2*)slabL + ((size_t)(((b * 4 + h) * NSC) * 8 + w) * 8) * 64 + lane;
#define HG_SLAB(m_) do { _Pragma("unroll") for (int kt = 0; kt < 8; ++kt) { const u32x2 l = lq[(m_) & 3][kt]; const f32x4 d = dt[(m_) * 32 + 4 * kt + g]; \
            S[kt] = S[kt] * d + (f32x4){__uint_as_float(l.x << 16), __uint_as_float(l.x & 0xffff0000u), __uint_as_float(l.y << 16), __uint_as_float(l.y & 0xffff0000u)}; } } while (0)
        int m = 0;
        for (; m + 3 < n; m += 4) { u32x2 lq[4][8];
#pragma unroll
            for (int q = 0; q < 4; ++q)
#pragma unroll
                for (int kt = 0; kt < 8; ++kt) lq[q][kt] = Lb[(size_t)(m + q) * 4096 + kt * 64];
            HG_SLAB(m); HG_SLAB(m + 1); HG_SLAB(m + 2); HG_SLAB(m + 3); }
        { u32x2 lq[4][8];
#pragma unroll
          for (int q = 0; q < 3; ++q) if (m + q < n) {
#pragma unroll
              for (int kt = 0; kt < 8; ++kt) lq[q][kt] = Lb[(size_t)(m + q) * 4096 + kt * 64]; }
          if (m < n) HG_SLAB(m);
          if (m + 1 < n) { const int m1 = m + 1; _Pragma("unroll") for (int kt = 0; kt < 8; ++kt) { const u32x2 l = lq[1][kt]; const f32x4 d = dt[m1 * 32 + 4 * kt + g]; S[kt] = S[kt] * d + (f32x4){__uint_as_float(l.x << 16), __uint_as_float(l.x & 0xffff0000u), __uint_as_float(l.y << 16), __uint_as_float(l.y & 0xffff0000u)}; } }
          if (m + 2 < n) { const int m2 = m + 2; _Pragma("unroll") for (int kt = 0; kt < 8; ++kt) { const u32x2 l = lq[2][kt]; const f32x4 d = dt[m2 * 32 + 4 * kt + g]; S[kt] = S[kt] * d + (f32x4){__uint_as_float(l.x << 16), __uint_as_float(l.x & 0xffff0000u), __uint_as_float(l.y << 16), __uint_as_float(l.y & 0xffff0000u)}; } } }
#undef HG_SLAB
    }
    HG_LOADRAW(0);
    float tsum = 0.f;
    HLAS unsigned short* const ow = (HLAS unsigned short*)(lds + OFF_OW) + w * 1024;
    const int trq0 = (4 * g + (x >> 2)) * ROWB + 8 * (x & 3), rr0 = x * ROWB + 8 * g;
    for (int grp = 0; grp < 4; ++grp) {
        HLAS char* pb = lds + (grp & 1) * BUFB;
        {
            float cum = 0.f; unsigned qp[8], kp[8], vp[8];
#pragma unroll
            for (int j = 0; j < 16; j += 2) {
                cum += lf[j];     const float e0 = __expf(cum), m0 = __expf(fminf(-cum, 80.f)), k0 = (1.f - __expf(lf[j])) * m0;
                cum += lf[j + 1]; const float e1 = __expf(cum), m1 = __expf(fminf(-cum, 80.f)), k1 = (1.f - __expf(lf[j + 1])) * m1;
                kp[j >> 1] = pkbf(k0, k1); vp[j >> 1] = vvp[j >> 1]; if (FULL) qp[j >> 1] = pkbf(__uint_as_float(qqp[j >> 1] << 16) * e0, __uint_as_float(qqp[j >> 1] & 0xffff0000u) * e1); }
            tsum += cum;
            typedef unsigned u32x2 __attribute__((ext_vector_type(2)));
            HLAS char* wr = pb + pk * ROWB + pcg * 32;
#pragma unroll
            for (int j = 0; j < 4; ++j) { *(HLAS u32x2*)(wr + OFF_KT + 8 * j) = (u32x2){kp[2 * j], kp[2 * j + 1]}; *(HLAS u32x2*)(wr + OFF_VT + 8 * j) = (u32x2){vp[2 * j], vp[2 * j + 1]};
                if (FULL) *(HLAS u32x2*)(wr + OFF_QT + 8 * j) = (u32x2){qp[2 * j], qp[2 * j + 1]}; }
            *(HLAS float*)(pb + OFF_DCH + (pcg * 128 + pk) * 4) = __expf(cum);
            if (grp < 3) HG_LOADRAW(grp + 1);
        }
        __syncthreads();
#define HG_FINALIZE(gp) do { const HLAS float* sq_ = (const HLAS float*)(lds + OFF_SSQ) + ((gp) & 1) * 512 + lane; float t_ = 0.f; \
            _Pragma("unroll") for (int w_ = 0; w_ < 8; ++w_) t_ += sq_[w_ * 64]; \
            const float rs_ = 1.f / sqrtf(t_ * (1.f / 128.f) + 1e-6f); const size_t r_ = row0 + 64 * (gp) + lane; \
            typedef unsigned u32x4_ __attribute__((ext_vector_type(4))); \
            const u32x4_ o0_ = *(const HLAS u32x4_*)(ow + lane * 16), o1_ = *(const HLAS u32x4_*)(ow + lane * 16 + 8); \
            const u32x4_ g0_ = *(const u32x4_*)(Gs + r_ * 512 + h * 128 + 16 * w), g1_ = *(const u32x4_*)(Gs + r_ * 512 + h * 128 + 16 * w + 8); \
            const float* gp_ = gain + h * 128 + 16 * w; u32x4_ y0_, y1_; \
            _Pragma("unroll") for (int j_ = 0; j_ < 4; ++j_) { \
                y0_[j_] = pkbf(__uint_as_float(o0_[j_] << 16) * rs_ * gp_[2 * j_] * __uint_as_float(g0_[j_] << 16), __uint_as_float(o0_[j_] & 0xffff0000u) * rs_ * gp_[2 * j_ + 1] * __uint_as_float(g0_[j_] & 0xffff0000u)); \
                y1_[j_] = pkbf(__uint_as_float(o1_[j_] << 16) * rs_ * gp_[8 + 2 * j_] * __uint_as_float(g1_[j_] << 16), __uint_as_float(o1_[j_] & 0xffff0000u) * rs_ * gp_[9 + 2 * j_] * __uint_as_float(g1_[j_] & 0xffff0000u)); } \
            *(u32x4_*)(MIXo + r_ * 1024 + 512 + h * 128 + 16 * w) = y0_; *(u32x4_*)(MIXo + r_ * 1024 + 512 + h * 128 + 16 * w + 8) = y1_; } while (0)
        if (FULL) { if (grp > 0) HG_FINALIZE(grp - 1); }
#pragma unroll
        for (int c = 0; c < 4; ++c) {
            const s16x4 vf = *(const HLAS s16x4*)(pb + OFF_VT + (16 * w) * ROWB + rr0 + c * 32);
            if (FULL) {
                s16x8 qf[4], kf[4];
#pragma unroll
                for (int s = 0; s < 4; ++s) {
                    const s16x4 a = trr(pb + OFF_QT + trq0 + s * 32 * ROWB + c * 32), bq = trr(pb + OFF_QT + trq0 + s * 32 * ROWB + 16 * ROWB + c * 32);
                    const s16x4 ck = trr(pb + OFF_KT + trq0 + s * 32 * ROWB + c * 32), dk = trr(pb + OFF_KT + trq0 + s * 32 * ROWB + 16 * ROWB + c * 32);
                    qf[s] = (s16x8){a[0], a[1], a[2], a[3], bq[0], bq[1], bq[2], bq[3]}; kf[s] = (s16x8){ck[0], ck[1], ck[2], ck[3], dk[0], dk[1], dk[2], dk[3]}; }
                f32x4 oacc = (f32x4){0.f, 0.f, 0.f, 0.f}, sc = (f32x4){0.f, 0.f, 0.f, 0.f};
#pragma unroll
                for (int s = 0; s < 4; ++s) {
                    typedef unsigned u32x4 __attribute__((ext_vector_type(4)));
                    const u32x4 sp = (u32x4){pkbf(S[2 * s][0], S[2 * s][1]), pkbf(S[2 * s][2], S[2 * s][3]), pkbf(S[2 * s + 1][0], S[2 * s + 1][1]), pkbf(S[2 * s + 1][2], S[2 * s + 1][3])};
                    mfma32_t(oacc, qf[s], __builtin_bit_cast(s16x8, sp));
                    mfma32_t(sc, kf[s], qf[s]); }
                asm volatile("s_nop 15" : "+v"(sc), "+v"(oacc) : "v"(qf[0]), "v"(qf[1]), "v"(qf[2]), "v"(qf[3]), "v"(kf[0]), "v"(kf[1]), "v"(kf[2]), "v"(kf[3]));
#pragma unroll
                for (int i = 0; i < 4; ++i) if (4 * g + i > x) sc[i] = 0.f;
                typedef unsigned u32x2 __attribute__((ext_vector_type(2)));
                const u32x2 pp = (u32x2){pkbf(sc[0], sc[1]), pkbf(sc[2], sc[3])};
                const s16x4 ppf = __builtin_bit_cast(s16x4, pp);
                mfma16_t(oacc, ppf, vf);
                asm volatile("s_nop 15" : "+v"(oacc));
                asm volatile("" : "+v"(oacc) : "v"(ppf), "v"(vf));
                { HLAS float* sq = (HLAS float*)(lds + OFF_SSQ) + (grp & 1) * 512 + w * 64 + 16 * c + 4 * g;
#pragma unroll
                  for (int i = 0; i < 4; ++i) { ow[(16 * c + 4 * g + i) * 16 + x] = (unsigned short)(pkbf(oacc[i], 0.f) & 0xffffu); const float s = row16_sum(oacc[i] * oacc[i]); if (x == 0) sq[i] = s; } }
            }
#pragma unroll
            for (int kt = 0; kt < 8; ++kt) {
                const s16x4 ka = *(const HLAS s16x4*)(pb + OFF_KT + (16 * kt) * ROWB + rr0 + c * 32);
                mfma16_t(S[kt], ka, vf); }
            asm volatile("s_nop 15" : "+v"(S[0]), "+v"(S[1]), "+v"(S[2]), "+v"(S[3]), "+v"(S[4]), "+v"(S[5]), "+v"(S[6]), "+v"(S[7]));
#pragma unroll
            for (int kt = 0; kt < 8; ++kt) S[kt] = S[kt] * *(const HLAS f32x4*)(pb + OFF_DCH + c * 512 + (16 * kt + 4 * g) * 4);
        }
    }
    if (FULL) { __syncthreads(); HG_FINALIZE(3); }
#undef HG_FINALIZE
#undef HG_LOADRAW
    if (!FULL) {
        typedef unsigned u32x2 __attribute__((ext_vector_type(2)));
        u32x2* L = (u32x2*)slabL + ((size_t)(unit * 8 + w) * 8) * 64 + lane;
#pragma unroll
        for (int kt = 0; kt < 8; ++kt) L[kt * 64] = (u32x2){pkbf(S[kt][0], S[kt][1]), pkbf(S[kt][2], S[kt][3])};
        HLAS float* tot = (HLAS float*)(lds + OFF_TOT);
        tot[pcg * 128 + pk] = tsum;
        __syncthreads();
        if (tid < 128) slabD[(size_t)unit * 128 + tid] = __expf(tot[tid] + tot[128 + tid] + tot[256 + tid] + tot[384 + tid]);
    } else if (n == NSC - 1) {
        float* so = state_out + ((size_t)(b * 4 + h) * 128) * 128 + 16 * w + x;
#pragma unroll
        for (int kt = 0; kt < 8; ++kt)
#pragma unroll
            for (int i = 0; i < 4; ++i) so[(size_t)(16 * kt + 4 * g + i) * 128] = S[kt][i];
    }
    __syncthreads();
}
#undef HLAS
}
#define GAS __attribute__((address_space(1)))
#define LAS __attribute__((address_space(3)))
typedef unsigned short bf16;
typedef unsigned v4u __attribute__((ext_vector_type(4)));
typedef float f32x4 __attribute__((ext_vector_type(4)));
typedef short bf16x8 __attribute__((ext_vector_type(8)));
typedef GAS unsigned gu32;
typedef GAS unsigned long long gu64;
#define RLX_AGENT __ATOMIC_RELAXED, __HIP_MEMORY_SCOPE_AGENT
#define LDS_WAIT() asm volatile("s_waitcnt lgkmcnt(0)" ::: "memory")
#define VM_WAIT() asm volatile("s_waitcnt vmcnt(0)" ::: "memory")
__device__ __forceinline__ unsigned long long rt() { return __builtin_amdgcn_s_memrealtime(); }
__device__ __forceinline__ unsigned f2bf(float f) { unsigned u = __builtin_bit_cast(unsigned, f); return (u + 0x7fffu + ((u >> 16) & 1u)) >> 16; }
__device__ __forceinline__ unsigned pk2(float lo, float hi) { return f2bf(lo) | (f2bf(hi) << 16); }

#define XB_TMO      128
#define XB_XCNT(j)  (256  + 64 * (j))
#define XB_XSUB(j)  (1280 + 64 * (j))
#define XB_XGEN(j)  (2304 + 64 * (j))
#define XB_TOP      3328
#define XB_TOPGEN   3392
#define XCD_BAR_WORDS 3456
#define XB_SPIN_CAP (1u << 18)

__device__ __forceinline__ unsigned xb_ld(unsigned* p)              { return __hip_atomic_load(p, __ATOMIC_RELAXED, __HIP_MEMORY_SCOPE_AGENT); }
__device__ __forceinline__ unsigned xb_add(unsigned* p, unsigned v) { return __hip_atomic_fetch_add(p, v, __ATOMIC_RELAXED, __HIP_MEMORY_SCOPE_AGENT); }
__device__ __forceinline__ unsigned xb_xcc_id() { return (unsigned)__builtin_amdgcn_s_getreg((3 << 11) | 20) & 0xFu; }
#define XB_SPIN(cond, bar) do { unsigned _sp = 0; while (cond) { __builtin_amdgcn_s_sleep(1); \
    if ((++_sp & 255u) == 0u) { if (xb_ld(&(bar)[XB_TMO])) break; if (_sp > XB_SPIN_CAP) { atomicAdd(&(bar)[XB_TMO], 1u); break; } } } } while (0)

struct XcdBarrier {
    unsigned* bar; unsigned x;
    volatile LAS unsigned* st;
};

__device__ __forceinline__ XcdBarrier xcd_barrier_post(unsigned* bar, volatile LAS unsigned* st) {
    XcdBarrier b; b.bar = bar; b.x = xb_xcc_id(); b.st = st;
    if (threadIdx.x == 0) (void)xb_add(&bar[XB_XCNT(b.x)], 1u);
    return b;
}
__device__ __forceinline__ void xcd_barrier_complete(unsigned* bar, unsigned x, unsigned& nloc, unsigned& nx) {
    const unsigned G = gridDim.x * gridDim.y * gridDim.z;
    unsigned sum, cnt, mine, sp = 0u;
    for (;;) {
        sum = 0u; cnt = 0u; mine = 0u;
#pragma unroll
        for (unsigned j = 0; j < 16; ++j) { const unsigned c = xb_ld(&bar[XB_XCNT(j)]); sum += c; cnt += (c > 0u) ? 1u : 0u; mine = (j == x) ? c : mine; }
        if (sum == G) break;
        __builtin_amdgcn_s_sleep(1);
        if ((++sp & 255u) == 0u) { if (xb_ld(&bar[XB_TMO])) break; if (sp > XB_SPIN_CAP) { atomicAdd(&bar[XB_TMO], 1u); break; } }
    }
    nloc = mine > 0u ? mine : 1u; nx = cnt > 0u ? cnt : 1u;
}

__device__ __forceinline__ void xcd_barrier(const XcdBarrier& b) {
    asm volatile("s_waitcnt vmcnt(0)" ::: "memory");
    __syncthreads();
    if (threadIdx.x == 0) {
        unsigned* bar = b.bar;
        __builtin_amdgcn_s_waitcnt(0);
        unsigned nloc = b.st[0], nx = b.st[1];
        if (nloc == 0u) { xcd_barrier_complete(bar, b.x, nloc, nx); b.st[0] = nloc; b.st[1] = nx; }
        const unsigned old = xb_add(&bar[XB_XSUB(b.x)], 1u);
        const unsigned gen = old / nloc;
        if (old + 1u == (gen + 1u) * nloc) {
            __builtin_amdgcn_fence(__ATOMIC_RELEASE, "agent");
            asm volatile("s_waitcnt vmcnt(0)" ::: "memory");
            const unsigned og = xb_add(&bar[XB_TOP], 1u);
            const unsigned tg = og / nx;
            if (og + 1u == (tg + 1u) * nx) xb_add(&bar[XB_TOPGEN], 1u);
            else XB_SPIN(xb_ld(&bar[XB_TOPGEN]) == tg, bar);
            __builtin_amdgcn_fence(__ATOMIC_ACQUIRE, "agent");
            xb_add(&bar[XB_XGEN(b.x)], 1u);
            asm volatile("s_waitcnt vmcnt(0)" ::: "memory");
        } else {
            XB_SPIN(xb_ld(&bar[XB_XGEN(b.x)]) == gen, bar);
            __builtin_amdgcn_fence(__ATOMIC_ACQUIRE, "agent");
            asm volatile("s_waitcnt vmcnt(0)" ::: "memory");
        }
    }
    __syncthreads();
}

struct Frame {
    LAS unsigned char* lds;
    volatile LAS unsigned* MISC;
    gu32* ctl;
    int tid, lane, wave, vcu, G;
    const float *xp, *xs, *cache_k, *cache_v, *state0; const int* ptab; const float *rel, *lbl;
    const float *n1, *wg1, *wu1, *wd1, *nmix, *win, *qn, *kn, *hn, *wout, *n2, *wg2, *wu2, *wd2;
    float* out;
    float *lb, *kmP, *kmS;
    bf16 *Wgu1, *Wd1, *Win, *Wout, *Wgu2, *Wd2, *XA, *MIX, *H, *QB, *KB, *VB;
    float *Dm, *D2, *D3, *X1, *X2, *REC, *Z, *GU, *GU2, *HL, *HD, *HF, *QS;
    bf16 *XA2, *XA3, *H2;
    float *SS0, *SS1, *SS2;
    bf16 *HQ, *HV, *HG;
    bf16* PO; float *PM, *PL, *TABG; int *LST, *CNT;
};
__device__ __forceinline__ float wave_sum(float v) {
#pragma unroll
    for (int o = 1; o < 64; o <<= 1) v += __shfl_xor(v, o);
    return v;
}
__device__ __forceinline__ float wave_max(float v) {
#pragma unroll
    for (int o = 1; o < 64; o <<= 1) v = fmaxf(v, __shfl_xor(v, o));
    return v;
}
__device__ __forceinline__ float silu_f(float x) { return x / (1.f + expf(-x)); }
__device__ __forceinline__ float bf2f(unsigned short u) { return __uint_as_float((unsigned)u << 16); }
__device__ __forceinline__ float sigmoid_f(float x) { return 1.f / (1.f + expf(-x)); }
template <int MODE>
__device__ __forceinline__ void p0_transpose_item(const float* W, const float* gain, int K, int N, bf16* WT, LAS float* scr, int item, int lane) {
    const int nblk = N / 32, kb = item / nblk, nb = item % nblk, k0 = 64 * kb, n0 = 32 * nb;
    const int rbase = MODE == 1 ? ((n0 & ~255) + 128 * ((n0 >> 5) & 1) + 32 * ((n0 >> 6) & 3)) : ((n0 >> 7) * 256 + (n0 & 127) + (MODE == 3 ? 128 : 0));
#pragma unroll 8
    for (int i = 0; i < 32; ++i) { const int kk = 2 * i + (lane >> 5); scr[kk * 33 + (lane & 31)] = W[(size_t)(k0 + kk) * N + n0 + (lane & 31)] * (gain ? gain[k0 + kk] : 1.f); }
    LDS_WAIT(); asm volatile("" ::: "memory");
    const int c = lane & 7;
#pragma unroll
    for (int j = 0; j < 4; ++j) { const int n = (lane >> 3) + 8 * j; const LAS float* s = scr + (8 * c) * 33 + n;
        v4u o; o.x = pk2(s[0 * 33], s[1 * 33]); o.y = pk2(s[2 * 33], s[3 * 33]); o.z = pk2(s[4 * 33], s[5 * 33]); o.w = pk2(s[6 * 33], s[7 * 33]);
        *(GAS v4u*)(WT + (size_t)(rbase + n) * K + k0 + 8 * c) = o; }
    LDS_WAIT(); asm volatile("" ::: "memory");
}
__device__ __forceinline__ const float* xrow(const Frame& F, int r) { return r < MP ? F.xp + (size_t)r * D : F.xs + (size_t)(r - MP) * D; }
__device__ __forceinline__ void rms_store_bf16(int lane, const f32x4 (&v)[4], const float* gain, bf16* orow) {
    float s = 0.f;
#pragma unroll
    for (int j = 0; j < 4; ++j) s += (v[j].x * v[j].x + v[j].y * v[j].y) + (v[j].z * v[j].z + v[j].w * v[j].w);
    const float rs = 1.f / sqrtf(wave_sum(s) * (1.f / D) + EPS);
    GAS unsigned long long* o8 = (GAS unsigned long long*)orow + lane;
#pragma unroll
    for (int j = 0; j < 4; ++j) { const f32x4 g = ((const GAS f32x4*)gain)[lane + 64 * j];
        o8[64 * j] = (unsigned long long)pk2(v[j].x * rs * g.x, v[j].y * rs * g.y) | ((unsigned long long)pk2(v[j].z * rs * g.z, v[j].w * rs * g.w) << 32); }
}
__device__ __forceinline__ void zero_row_bf16(int lane, bf16* orow) {
    GAS unsigned long long* o8 = (GAS unsigned long long*)orow + lane;
#pragma unroll
    for (int j = 0; j < 4; ++j) o8[64 * j] = 0ull;
}
__device__ __forceinline__ void p0_prologue(Frame& F) {
    LAS float* scr = (LAS float*)(F.lds + RING_OFF + F.wave * 16384);
    const int gw = F.vcu * NWAVES + F.wave, NGW = F.G * NWAVES;
    constexpr int I_G = (D / 64) * (FF / 32), I_D = (FF / 64) * (D / 32), I_IN = (D / 64) * (NIN / 32), I_O = (D / 64) * (D / 32);
    constexpr int NITEMS = 4 * I_G + 2 * I_D + I_IN + I_O;
    for (int it = gw; it < NITEMS; it += NGW) {
        int r = it;
        if (r < I_G) { p0_transpose_item<2>(F.wg1, F.n1, D, FF, F.Wgu1, scr, r, F.lane); continue; } r -= I_G;
        if (r < I_G) { p0_transpose_item<3>(F.wu1, F.n1, D, FF, F.Wgu1, scr, r, F.lane); continue; } r -= I_G;
        if (r < I_G) { p0_transpose_item<2>(F.wg2, F.n2, D, FF, F.Wgu2, scr, r, F.lane); continue; } r -= I_G;
        if (r < I_G) { p0_transpose_item<3>(F.wu2, F.n2, D, FF, F.Wgu2, scr, r, F.lane); continue; } r -= I_G;
        if (r < I_D) { p0_transpose_item<1>(F.wd1, nullptr, FF, D, F.Wd1, scr, r, F.lane); continue; } r -= I_D;
        if (r < I_D) { p0_transpose_item<1>(F.wd2, nullptr, FF, D, F.Wd2, scr, r, F.lane); continue; } r -= I_D;
        if (r < I_IN) { p0_transpose_item<1>(F.win, F.nmix, D, NIN, F.Win, scr, r, F.lane); continue; } r -= I_IN;
        p0_transpose_item<1>(F.wout, nullptr, D, D, F.Wout, scr, r, F.lane);
    }
    if (gw == 0) { for (int j = F.lane; j < 512; j += 64) F.lb[j] = sigmoid_f(F.lbl[j] - F.lbl[512 + j]); }
    for (int m = gw; m < M_ALL; m += NGW) {
        if (m < MR) { const GAS f32x4* xr = (const GAS f32x4*)xrow(F, m) + F.lane; GAS unsigned long long* o8 = (GAS unsigned long long*)(F.XA + (size_t)m * D) + F.lane; float s = 0.f;
#pragma unroll
            for (int j = 0; j < 4; ++j) { const f32x4 v = xr[64 * j]; s += (v.x * v.x + v.y * v.y) + (v.z * v.z + v.w * v.w); o8[64 * j] = (unsigned long long)pk2(v.x, v.y) | ((unsigned long long)pk2(v.z, v.w) << 32); }
            s = wave_sum(s); if (F.lane == 0) F.SS0[m] = s; }
        else { zero_row_bf16(F.lane, F.XA + (size_t)m * D); zero_row_bf16(F.lane, F.XA2 + (size_t)m * D); zero_row_bf16(F.lane, F.XA3 + (size_t)m * D); if (F.lane == 0) F.SS0[m] = 0.f; }
    }
}
constexpr int CW_Q1 = 1024, CW_Q3 = 1088;
__device__ __forceinline__ void kms_queue(Frame& F, int cw, int first, int count) {
    LAS f32x4* red = (LAS f32x4*)(F.lds + RING_OFF);
    LAS int* slot = (LAS int*)(F.lds + RING_OFF + 8192);
    int tq = F.tid; asm volatile("" : "+v"(tq)); const int rq = tq >> 7, c4 = tq & 127;
    for (;;) {
        if (F.tid == 0) slot[0] = (int)__hip_atomic_fetch_add((unsigned*)(F.ctl + cw), 1u, __ATOMIC_RELAXED, __HIP_MEMORY_SCOPE_AGENT);
        __syncthreads();
        const int q = slot[0];
        if (q >= count) break;
        const int it = first + q, sb = it / NBS, blk = it % NBS; f32x4 a = (f32x4){0.f, 0.f, 0.f, 0.f};
        const int page0 = F.ptab[sb * NPG + blk * 2], page1 = F.ptab[sb * NPG + blk * 2 + 1];
#pragma unroll
        for (int pg = 0; pg < 2; ++pg) { const GAS f32x4* base = (const GAS f32x4*)(F.cache_k + (size_t)(pg ? page1 : page0) * PAGE * AW) + c4 + rq * (AW / 4); f32x4 v[32];
#pragma unroll
            for (int s = 0; s < 32; ++s) v[s] = __builtin_nontemporal_load(base + (size_t)s * AW);
#pragma unroll
            for (int s = 0; s < 32; s += 2) a += v[s] + v[s + 1]; }
        red[rq * 128 + c4] = a;
        __syncthreads();
        if (F.tid < 128) { const f32x4 r = (red[F.tid] + red[128 + F.tid]) + (red[256 + F.tid] + red[384 + F.tid]); ((GAS f32x4*)(F.kmS + (size_t)it * AW))[F.tid] = r * (1.f / MOBA); }
        __syncthreads();
    }
    __syncthreads();
}
__device__ __forceinline__ int rel_bucket(int n) { return n < 16 ? n : min(31, 39 - __clz(n * n)); }
__device__ __forceinline__ void hgrn_prompt_phase1(Frame& F) {
    for (int u = F.vcu; u < PB * BH * hg::NSC; u += F.G)
        hg::hgrn_unit<false>(u >> 6, (u >> 4) & 3, u & 15, F.HQ, BW, F.HF, BW, F.HV, BW, F.HG, F.hn, F.MIX, F.HL, F.HD, F.out + OFF_SP, (__attribute__((address_space(3))) char*)(F.lds + RING_OFF));
}
__device__ __forceinline__ void hgrn_prompt_phase2(Frame& F) {
    for (int u = F.vcu; u < PB * BH * hg::NSC; u += F.G)
        hg::hgrn_unit<true>(u >> 6, (u >> 4) & 3, u & 15, F.HQ, BW, F.HF, BW, F.HV, BW, F.HG, F.hn, F.MIX, F.HL, F.HD, F.out + OFF_SP, (__attribute__((address_space(3))) char*)(F.lds + RING_OFF));
}
constexpr int CW_QA = 1152, CW_QB = 1216, CW_TOT = 2048;
constexpr int MB_PRE_OFF = RING_OFF + 118784, MB_SLOT_OFF = MB_PRE_OFF + 2304;
__device__ __forceinline__ void p0_tabg(Frame& F) {
    for (int i = (F.vcu * NWAVES + F.wave) * 64 + F.lane; i < AH * moba::TAB_N; i += F.G * NWAVES * 64) { const int h = i >> 12, d = i & 4095; F.TABG[h * moba::TAB_N + (moba::TAB_N - 1 - d)] = F.rel[rel_bucket(d) * AH + h] * moba::LOG2E; }
}
__device__ __forceinline__ void moba_select_item(Frame& F, int it) {
    const int b = it / 60, r_ = it % 60, n = 1 + (r_ >> 2), hp = r_ & 3;
    int tq = F.tid; asm volatile("" : "+v"(tq));
    const int half = tq >> 8, tl = tq & 255, h = 2 * hp + half, bh = b * AH + h, w4 = F.wave & 3;
    LAS float* kml = (LAS float*)(F.lds + RING_OFF);
    LAS int* wc = (LAS int*)(F.lds + RING_OFF + 8192);
    for (int i = tq; i < 2 * n * 16; i += NWAVES * 64) { const int hh = i / (n * 16), rem = i - hh * n * 16, nn = rem >> 4, c = rem & 15;
        *(LAS f32x4*)(kml + (hh * 15 + nn) * 64 + c * 4) = *(const GAS f32x4*)(F.kmP + ((size_t)(b * NBP + nn) * AW + (2 * hp + hh) * AD) + c * 4); }
    bf16x8 qv[8];
    { const bf16x8* qp = (const bf16x8*)(F.QB + (size_t)(b * PT + MOBA * n + tl) * AW + h * AD);
#pragma unroll
      for (int c = 0; c < 8; ++c) qv[c] = qp[c]; }
    __syncthreads();
    unsigned selm;
    if (n <= 3) selm = (1u << n) - 1u;
    else {
        float g0 = -INFINITY, g1 = -INFINITY, g2 = -INFINITY; int i0 = 0, i1 = 0, i2 = 0;
        for (int nn = 0; nn < n; ++nn) {
            const LAS float* km = kml + (half * 15 + nn) * 64;
            float a = 0.f;
#pragma unroll
            for (int c = 0; c < 8; ++c) { const f32x4 k0_ = *(const LAS f32x4*)(km + c * 8), k1_ = *(const LAS f32x4*)(km + c * 8 + 4);
#pragma unroll
                for (int j = 0; j < 4; ++j) { a += bf2f((unsigned short)qv[c][j]) * k0_[j]; a += bf2f((unsigned short)qv[c][4 + j]) * k1_[j]; } }
            const bool c0 = a > g0, c1 = a > g1, c2 = a > g2;
            g2 = c1 ? g1 : (c2 ? a : g2); i2 = c1 ? i1 : (c2 ? nn : i2);
            g1 = c0 ? g0 : (c1 ? a : g1); i1 = c0 ? i0 : (c1 ? nn : i1);
            g0 = c0 ? a : g0;             i0 = c0 ? nn : i0;
        }
        selm = (1u << i0) | (1u << i1) | (1u << i2);
    }
    for (int j = 0; j < n; ++j) { const unsigned long long bal = __ballot((selm >> j) & 1u); if (F.lane == 0) wc[(half * 16 + j) * 4 + w4] = (int)__popcll(bal); }
    __syncthreads();
    for (int j = 0; j < n; ++j) {
        const bool s_ = ((selm >> j) & 1u) != 0u; const unsigned long long bal = __ballot(s_);
        const LAS int* w_ = wc + (half * 16 + j) * 4; const int c0 = w_[0], c1 = w_[1], c2 = w_[2], c3 = w_[3];
        const int base = (w4 > 0 ? c0 : 0) + (w4 > 1 ? c1 : 0) + (w4 > 2 ? c2 : 0);
        if (s_) { const int pos = base + (int)__builtin_amdgcn_mbcnt_hi((unsigned)(bal >> 32), __builtin_amdgcn_mbcnt_lo((unsigned)bal, 0u)); const int slot = __popc(selm & ((1u << j) - 1u));
                  F.LST[(size_t)((bh * 15 + j) * 16 + n) * 256 + pos] = tl | (slot << 8); }
        if (tl == 0) { const int tot = c0 + c1 + c2 + c3; F.CNT[(bh * 15 + j) * 16 + n] = tot; (void)__hip_atomic_fetch_add((unsigned*)(F.ctl + CW_TOT + j * 32 + bh), (unsigned)tot, RLX_AGENT); }
    }
    __syncthreads();
}
__device__ __forceinline__ void moba_select_phase(Frame& F) {
    __syncthreads();
    for (int it = F.vcu; it < PB * 15 * 4; it += F.G) moba_select_item(F, it);
}
__device__ __forceinline__ void moba_tab_dma(Frame& F, int h, unsigned lds0) {
#pragma unroll
    for (int q = 0; q < 2; ++q) { const int ch = F.wave + 8 * q; moba::glds16(F.TABG + (size_t)h * moba::TAB_N + ch * 256 + F.lane * 4, (unsigned)__builtin_amdgcn_readfirstlane(lds0 + moba::LDS_TAB + ch * 1024)); }
}
__device__ __forceinline__ void moba_phaseA(Frame& F) {
    __syncthreads();
    char* shm = (char*)F.lds + RING_OFF;
    const unsigned lds0 = (unsigned)(uintptr_t)shm;
    LAS int* pre = (LAS int*)(F.lds + MB_PRE_OFF); LAS int* slot = (LAS int*)(F.lds + MB_SLOT_OFF);
    { const int e = F.tid; unsigned x = 0u; if (e < 480) { const unsigned tot = __hip_atomic_load((unsigned*)(F.ctl + CW_TOT + e), RLX_AGENT); x = (e >> 5) < 6 ? ((tot + 1023u) >> 10) : ((tot + 511u) >> 9); }
#pragma unroll
      for (int o = 1; o < 64; o <<= 1) { const unsigned v = __shfl_up(x, o); if (F.lane >= o) x += v; }
      if (F.lane == 63) pre[516 + F.wave] = (int)x;
      __syncthreads();
      unsigned add = 0u; for (int w = 0; w < F.wave; ++w) add += (unsigned)pre[516 + w];
      pre[e + 1] = (int)(x + add); if (e == 0) pre[0] = 0;
      __syncthreads(); }
    const int total = __builtin_amdgcn_readfirstlane(pre[480]);
    for (;;) {
        if (F.tid == 0) slot[0] = (int)__hip_atomic_fetch_add((unsigned*)(F.ctl + CW_QA), 1u, RLX_AGENT);
        __syncthreads();
        const int k = __builtin_amdgcn_readfirstlane(slot[0]);
        if (k >= total) break;
        int lo_ = 0, hi_ = 480;
        while (hi_ - lo_ > 1) { const int mid = (lo_ + hi_) >> 1; if (__builtin_amdgcn_readfirstlane(pre[mid]) <= k) lo_ = mid; else hi_ = mid; }
        const int e = lo_, c = k - __builtin_amdgcn_readfirstlane(pre[e]), j = e >> 5, bh = e & 31, b = bh >> 3, h = bh & 7;
        { int ln = F.lane; asm volatile("" : "+v"(ln));
          const bf16* ksrc = F.KB + ((size_t)b * PT + MOBA * j + ln) * AW + h * AD + F.wave * 8;
          const bf16* vsrc = F.VB + ((size_t)b * PT + MOBA * j + 16 * (F.wave & 3) + (ln >> 2)) * AW + h * AD + (F.wave >> 2) * 32 + (ln & 3) * 8;
          moba_tab_dma(F, h, lds0);
#pragma unroll
          for (int t = 0; t < 4; ++t) { moba::glds16(ksrc + (size_t)(64 * t) * AW, (unsigned)__builtin_amdgcn_readfirstlane(lds0 + moba::LDS_K + F.wave * 1024 + t * moba::SLOTB));
                                        moba::glds16(vsrc + (size_t)(64 * t) * AW, (unsigned)__builtin_amdgcn_readfirstlane(lds0 + moba::LDS_V + F.wave * 1024 + t * moba::SLOTB)); } }
        int cnt_l = 0; if (F.lane > j && F.lane < 16) cnt_l = F.CNT[(bh * 15 + j) * 16 + F.lane];
        int inc = cnt_l;
#pragma unroll
        for (int o = 1; o < 16; o <<= 1) { const int v = __shfl_up(inc, o); if (F.lane >= o) inc += v; }
        const int exc = inc - cnt_l, tot = __builtin_amdgcn_readlane(inc, 15), T = (tot + 31) >> 5, CH = j < 6 ? 32 : 16, gend = min(CH * c + CH, T);
        asm volatile("s_waitcnt vmcnt(0)" ::: "memory");
        __syncthreads();
        for (int g = CH * c + F.wave; g < gend; g += NWAVES) {
            const int p = 32 * g + (F.lane & 31), pc = p < tot ? p : tot - 1;
            int nsel = j + 1, idx = 0;
            for (int n = j + 1; n < 16; ++n) { const int on = __builtin_amdgcn_readlane(exc, n), cn = __builtin_amdgcn_readlane(cnt_l, n); if (pc >= on && pc < on + cn) { nsel = n; idx = pc - on; } }
            const int ent = F.LST[(size_t)((bh * 15 + j) * 16 + nsel) * 256 + idx];
            const int gq = MOBA * nsel + (ent & 255), sl = ent >> 8;
            const int grec = p < tot ? ((bh * 3 + sl) * PT + gq) : -1;
            moba::moba_core<8, true>(b, h, j, gq, grec, (const moba::bf16h*)F.QB, (const moba::bf16h*)F.KB, (const moba::bf16h*)F.VB, (moba::bf16h*)F.MIX, (moba::bf16h*)F.PO, F.PM, F.PL, shm);
        }
        __syncthreads();
    }
    __syncthreads();
}
__device__ __forceinline__ void moba_phaseB(Frame& F) {
    __syncthreads();
    char* shm = (char*)F.lds + RING_OFF;
    const unsigned lds0 = (unsigned)(uintptr_t)shm;
    LAS int* slot = (LAS int*)(F.lds + MB_SLOT_OFF);
    for (;;) {
        if (F.tid == 0) slot[0] = (int)__hip_atomic_fetch_add((unsigned*)(F.ctl + CW_QB), 1u, RLX_AGENT);
        __syncthreads();
        const int k = __builtin_amdgcn_readfirstlane(slot[0]);
        if (k >= PB * AH * NBP) break;
        const int bh = k >> 4, n = 15 - (k & 15), b = bh >> 3, h = bh & 7;
        moba_tab_dma(F, h, lds0);
        moba::moba_core<8, false>(b, h, n, 0, 0, (const moba::bf16h*)F.QB, (const moba::bf16h*)F.KB, (const moba::bf16h*)F.VB, (moba::bf16h*)F.MIX, (moba::bf16h*)F.PO, F.PM, F.PL, shm);
    }
    __syncthreads();
}
constexpr int SMP_SEL = 0, SMP_PART = 256, SMP_PSTR = 68;
__device__ __forceinline__ void moba_sample_unit(Frame& F, int sb, int h) {
    const int lane = F.lane, kq = lane >> 4, d4 = lane & 15, w = F.wave;
    const int relh = __float_as_int(F.rel[(lane & 31) * AH + h]);
    LAS int* sel = (LAS int*)(F.lds + RING_OFF + SMP_SEL);
    LAS float* part = (LAS float*)(F.lds + RING_OFF + SMP_PART);
    if (w < ST) {
        const int t = w; const f32x4* qp = (const f32x4*)(F.QS + (size_t)(sb * ST + t) * AW + h * AD); const f32x4* km = (const f32x4*)(F.kmS + (size_t)(sb * NBS + (lane & 31)) * AW + h * AD);
        float g = 0.f;
#pragma unroll
        for (int i = 0; i < 16; ++i) { const f32x4 q = qp[i], kv = km[i]; g += (q.x * kv.x + q.y * kv.y) + (q.z * kv.z + q.w * kv.w); }
        if (lane >= NBS) g = -INFINITY;
#pragma unroll
        for (int j = 0; j < 3; ++j) {
            float bv = g; int bi = lane;
#pragma unroll
            for (int o = 32; o >= 1; o >>= 1) { const float ov = __shfl_xor(bv, o); const int oi = __shfl_xor(bi, o); if (ov > bv || (ov == bv && oi < bi)) { bv = ov; bi = oi; } }
            if (lane == 0) sel[t * 4 + j] = bi;
            if (lane == bi) g = -INFINITY;
        }
    }
    __syncthreads();
    for (int ht = w; ht < 24; ht += NWAVES) {
        const int t = ht / 6, j = (ht % 6) >> 1, half = ht & 1, blk = sel[t * 4 + j];
        const int page = F.ptab[sb * NPG + blk * 2 + half];
        unsigned lo4 = (unsigned)(kq * (AW / 4) + d4); asm volatile("" : "+v"(lo4));
        const GAS f32x4* kb = (const GAS f32x4*)(F.cache_k + ((size_t)page * PAGE * AH + h) * AD) + lo4;
        const GAS f32x4* vb = (const GAS f32x4*)(F.cache_v + ((size_t)page * PAGE * AH + h) * AD) + lo4;
        const f32x4 q4 = *((const f32x4*)(F.QS + (size_t)(sb * ST + t) * AW + h * AD) + d4);
        const int dist0 = PAST + t - (blk * MOBA + half * PAGE + kq);
        float sv[32]; float m = -INFINITY;
#pragma unroll
        for (int i0 = 0; i0 < 32; i0 += 32) { f32x4 kv[32];
#pragma unroll
            for (int i = 0; i < 32; ++i) kv[i] = __builtin_nontemporal_load(kb + (unsigned)((i0 + i) * AW));
#pragma unroll
            for (int i = 0; i < 32; ++i) { float dt = (q4.x * kv[i].x + q4.y * kv[i].y) + (q4.z * kv[i].z + q4.w * kv[i].w);
                dt = hg::row16_sum(dt);
                const float s = dt * 0.125f + __int_as_float(__builtin_amdgcn_ds_bpermute(rel_bucket(dist0 - 4 * (i0 + i)) * 4, relh)); sv[i0 + i] = s; m = fmaxf(m, s); } }
        f32x4 vv0[16], vv1[16];
#pragma unroll
        for (int i = 0; i < 16; ++i) vv0[i] = __builtin_nontemporal_load(vb + (unsigned)(i * AW));
#pragma unroll
        for (int i = 0; i < 16; ++i) vv1[i] = __builtin_nontemporal_load(vb + (unsigned)((16 + i) * AW));
        m = fmaxf(m, __shfl_xor(m, 16)); m = fmaxf(m, __shfl_xor(m, 32));
        float l = 0.f;
#pragma unroll
        for (int i = 0; i < 32; ++i) { sv[i] = __expf(sv[i] - m); l += sv[i]; }
        l += __shfl_xor(l, 16); l += __shfl_xor(l, 32);
        f32x4 acc = (f32x4){0.f, 0.f, 0.f, 0.f};
        {
#pragma unroll
          for (int i = 0; i < 16; ++i) acc += vv0[i] * sv[i];
#pragma unroll
          for (int i = 0; i < 16; ++i) acc += vv1[i] * sv[16 + i]; }
#pragma unroll
        for (int c = 0; c < 4; ++c) { acc[c] += __shfl_xor(acc[c], 16); acc[c] += __shfl_xor(acc[c], 32); }
        LAS float* pp = part + ht * SMP_PSTR;
        if (lane < 16) *(LAS f32x4*)(pp + 4 + 4 * d4) = acc;
        if (lane == 0) { pp[0] = m; pp[1] = l; }
    }
    __syncthreads();
    if (w < ST) {
        const int t = w; const float* qp = F.QS + (size_t)(sb * ST + t) * AW + h * AD;
        float so[ST]; float mall = -INFINITY;
#pragma unroll
        for (int o = 0; o < ST; ++o) { so[o] = -INFINITY;
            if (o <= t) { const float dt = wave_sum(qp[lane] * F.out[OFF_KS + (size_t)(sb * ST + o) * AW + h * AD + lane]); so[o] = dt * 0.125f + F.rel[(t - o) * AH + h]; mall = fmaxf(mall, so[o]); } }
#pragma unroll
        for (int p = 0; p < 6; ++p) mall = fmaxf(mall, part[(6 * t + p) * SMP_PSTR]);
        float L = 0.f, o_ = 0.f;
#pragma unroll
        for (int p = 0; p < 6; ++p) { const LAS float* pp = part + (6 * t + p) * SMP_PSTR; const float wgt = __expf(pp[0] - mall); L += pp[1] * wgt; o_ += pp[4 + lane] * wgt; }
#pragma unroll
        for (int o = 0; o < ST; ++o) if (o <= t) { const float e = __expf(so[o] - mall); L += e; o_ += e * F.out[OFF_VS + (size_t)(sb * ST + o) * AW + h * AD + lane]; }
        F.MIX[(size_t)(MP + sb * ST + t) * D + h * AD + lane] = (bf16)f2bf(o_ / L);
    }
    __syncthreads();
}
__device__ __forceinline__ void hgrn_sample_unit(Frame& F, int seq, int h) {
    const int lane = F.lane, vi = lane >> 2, kc = lane & 3, w = F.wave, v = 16 * w + vi;
    LAS float* part = (LAS float*)(F.lds + RING_OFF);
    const unsigned sbase = (unsigned)(((seq * BH + h) * BKD + 32 * kc) * BVD + v);
    float S[32]; float ot[ST];
#pragma unroll
    for (int i = 0; i < 32; ++i) S[i] = F.state0[sbase + (unsigned)(i * BVD)];
#pragma unroll
    for (int t = 0; t < ST; ++t) {
        const unsigned r = (unsigned)(MP + seq * ST + t) * BW + h * BKD;
        const float vv = bf2f(F.HV[r + v]); float o = 0.f;
#pragma unroll
        for (int i4 = 0; i4 < 8; ++i4) { const unsigned long long qb4 = *(const unsigned long long*)(F.HQ + r + 32 * kc + 4 * i4); const f32x4 q = (f32x4){bf2f((unsigned short)qb4), bf2f((unsigned short)(qb4 >> 16)), bf2f((unsigned short)(qb4 >> 32)), bf2f((unsigned short)(qb4 >> 48))}, lf = *(const f32x4*)(F.HF + r + 32 * kc + 4 * i4);
#pragma unroll
            for (int j = 0; j < 4; ++j) { const float f = __expf(lf[j]); S[4 * i4 + j] = f * S[4 * i4 + j] + (1.f - f) * vv; o += S[4 * i4 + j] * q[j]; } }
        o += __shfl_xor(o, 1); o += __shfl_xor(o, 2); ot[t] = o;
        float s = o * o; s += __shfl_xor(s, 4); s += __shfl_xor(s, 8); s += __shfl_xor(s, 16); s += __shfl_xor(s, 32);
        if (lane == 0) part[t * 8 + w] = s;
    }
    float* const sout = F.out + OFF_SS;
#pragma unroll
    for (int i = 0; i < 32; ++i) sout[sbase + (unsigned)(i * BVD)] = S[i];
    __syncthreads();
    if (kc == 0) {
#pragma unroll
        for (int t = 0; t < ST; ++t) { float tot = 0.f;
#pragma unroll
            for (int ww = 0; ww < 8; ++ww) tot += part[t * 8 + ww];
            const unsigned r = (unsigned)(MP + seq * ST + t);
            const float y = ot[t] * (1.f / sqrtf(tot * (1.f / BVD) + EPS)) * F.hn[h * BVD + v] * bf2f(F.HG[r * BW + h * BVD + v]);
            F.MIX[(size_t)r * D + AW + h * BVD + v] = (bf16)f2bf(y); }
    }
    __syncthreads();
}
template <int PART> __device__ __forceinline__ void ph_mixers(Frame& F) {
#define SAMPLE_HGRN() do { if (F.G == PB * BH * hg::NSC) { if ((F.vcu & 15) < 8) { const int j = (F.vcu >> 4) * 8 + (F.vcu & 7); hgrn_sample_unit(F, j >> 2, j & 3); } } \
        else for (int u = F.vcu; u < SB * BH; u += F.G) hgrn_sample_unit(F, u >> 2, u & 3); } while (0)
    __syncthreads();
    if (F.G == SB * AH) {
        const int o = F.vcu >> 1; int ns = 0, s0 = 0;
        if ((PART == 0) == ((F.vcu & 1) != 0)) { if (PART == 0) { if ((o & 3) != 3) { ns = 2; s0 = 2 * ((o >> 2) * 3 + (o & 3)); } } else if ((o & 1) == 0) { ns = 1; s0 = 192 + (o >> 1); } }
        else { hgrn_prompt_phase2(F); SAMPLE_HGRN(); }
#pragma nounroll
        for (int i = 0; i < ns; ++i) moba_sample_unit(F, (s0 + i) >> 3, (s0 + i) & 7);
    } else {
    if ((PART == 0) == ((F.vcu & 1) != 0)) { for (int u = F.vcu; u < SB * AH; u += F.G) moba_sample_unit(F, u >> 3, u & 7); }
    else { hgrn_prompt_phase2(F); SAMPLE_HGRN(); }
    }
    if (PART == 0) moba_phaseA(F); else moba_phaseB(F);
#undef SAMPLE_HGRN
}
constexpr int SRS_OFF = LDSCTL_OFF + 1024;
template <int K>
__device__ __forceinline__ void small_gemm(Frame& F, const bf16* A, const bf16* Bt, const float* base, float* xo, bf16* xa, float sc) {
    typedef float f32x4v __attribute__((ext_vector_type(4)));
    int lane = F.lane; asm volatile("" : "+v"(lane)); const int x = lane & 15, g = lane >> 4, kq = F.wave & 3; constexpr int KQ = K / 4, NS = KQ / 32;
    LAS f32x4v* red = (LAS f32x4v*)(F.lds + RING_OFF);
    for (int t0 = 2 * F.vcu; t0 < 512; t0 += 2 * F.G) {
        const int tile = t0 + (F.wave >> 2), rt = tile >> 6, st = tile & 63, col = 16 * st + x;
        const int wr_ = (col & ~255) + 128 * ((col >> 5) & 1) + 32 * ((col >> 6) & 3) + (col & 31);
        const bf16x8* ap = (const bf16x8*)(A + (size_t)(16 * rt + x) * K + kq * KQ + 8 * g); const bf16x8* bp = (const bf16x8*)(Bt + (size_t)wr_ * K + kq * KQ + 8 * g);
        f32x4v acc = (f32x4v){0.f, 0.f, 0.f, 0.f};
#pragma unroll
        for (int s0 = 0; s0 < NS; s0 += 11) { bf16x8 af[11], bfr[11];
#pragma unroll
            for (int s = 0; s < 11; ++s) if (s0 + s < NS) { af[s] = ap[(s0 + s) * 4]; bfr[s] = bp[(s0 + s) * 4]; }
#pragma unroll
            for (int s = 0; s < 11; ++s) if (s0 + s < NS) asm volatile("v_mfma_f32_16x16x32_bf16 %0, %1, %2, %0" : "+v"(acc) : "v"(af[s]), "v"(bfr[s])); }
        asm volatile("s_nop 15\n\ts_nop 15" : "+v"(acc));
        red[((F.wave >> 2) * 4 + kq) * 64 + lane] = acc;
        __syncthreads();
        if (kq == 0) { const LAS f32x4v* r = red + (F.wave >> 2) * 256 + lane; const f32x4v v = (r[0] + r[64]) + (r[128] + r[192]);
#pragma unroll
            for (int i = 0; i < 4; ++i) { const size_t o = (size_t)(16 * rt + 4 * g + i) * D + col; const float y = base[o] + sc * v[i]; xo[o] = y; if (xa) xa[o] = (bf16)f2bf(y); } }
        __syncthreads();
    }
}
__device__ __forceinline__ void sample_rs_to_lds(Frame& F, const float* X) {
    LAS float* tab = (LAS float*)(F.lds + SRS_OFF); int ln = F.lane; asm volatile("" : "+v"(ln));
    for (int r0 = 16 * F.wave; r0 < 16 * F.wave + 16; r0 += 8) {
        f32x4 v[8][4]; float s[8];
#pragma unroll
        for (int i = 0; i < 8; ++i)
#pragma unroll
            for (int j = 0; j < 4; ++j) v[i][j] = ((const GAS f32x4*)(X + (size_t)(r0 + i) * D) + ln)[64 * j];
#pragma unroll
        for (int i = 0; i < 8; ++i) { s[i] = 0.f;
#pragma unroll
            for (int j = 0; j < 4; ++j) s[i] += (v[i][j].x * v[i][j].x + v[i][j].y * v[i][j].y) + (v[i][j].z * v[i][j].z + v[i][j].w * v[i][j].w); }
#pragma unroll
        for (int o = 1; o < 64; o <<= 1)
#pragma unroll
            for (int i = 0; i < 8; ++i) s[i] += __shfl_xor(s[i], o);
#pragma unroll
        for (int i = 0; i < 8; ++i) if (ln == 0) tab[r0 + i] = 1.f / sqrtf(s[i] * (1.f / D) + EPS);
    }
    __syncthreads();
}

__device__ __forceinline__ void refresh(Frame& F) { int t = threadIdx.x; asm volatile("" : "+v"(t)); F.tid = t; F.lane = t & 63; }
constexpr int NPHASE = 10;
struct Args { const void* in[22]; float* out; unsigned char* ws; int ph_lo, ph_hi; };
__global__ void __launch_bounds__(NWAVES * 64, 2) mk_fwd(Args args) {
    extern __shared__ __attribute__((aligned(16))) unsigned char lds[];
    Frame F;
    F.lds = (LAS unsigned char*)lds;
    F.MISC = (volatile LAS unsigned*)(F.lds + MISC_OFF);
    F.tid = threadIdx.x; F.lane = F.tid & 63; F.wave = __builtin_amdgcn_readfirstlane(F.tid >> 6);
    F.G = gridDim.x; { const int bx = blockIdx.x; F.vcu = (F.G % 8 == 0) ? (bx % 8) * (F.G / 8) + bx / 8 : bx; }
    unsigned char* ws = args.ws;
    F.ctl = (gu32*)(ws + WS_CTL);
    F.xp = (const float*)args.in[0]; F.xs = (const float*)args.in[1]; F.cache_k = (const float*)args.in[2]; F.cache_v = (const float*)args.in[3]; F.state0 = (const float*)args.in[4];
    F.ptab = (const int*)args.in[5]; F.rel = (const float*)args.in[6]; F.lbl = (const float*)args.in[7];
    F.n1 = (const float*)args.in[8]; F.wg1 = (const float*)args.in[9]; F.wu1 = (const float*)args.in[10]; F.wd1 = (const float*)args.in[11];
    F.nmix = (const float*)args.in[12]; F.win = (const float*)args.in[13]; F.qn = (const float*)args.in[14]; F.kn = (const float*)args.in[15]; F.hn = (const float*)args.in[16];
    F.wout = (const float*)args.in[17]; F.n2 = (const float*)args.in[18]; F.wg2 = (const float*)args.in[19]; F.wu2 = (const float*)args.in[20]; F.wd2 = (const float*)args.in[21];
    F.out = args.out;
    F.lb = (float*)(ws + WS_SMALL); F.kmP = (float*)(ws + WS_CTL + 512 * 1024)  ; F.kmS = (float*)(ws + WS_KMS);
    F.Wgu1 = (bf16*)(ws + WS_WGU1); F.Wd1 = (bf16*)(ws + WS_WD1); F.Win = (bf16*)(ws + WS_WIN); F.Wout = (bf16*)(ws + WS_WOUT); F.Wgu2 = (bf16*)(ws + WS_WGU2); F.Wd2 = (bf16*)(ws + WS_WD2);
    F.QB = (bf16*)(ws + WS_QB); F.KB = (bf16*)(ws + WS_KB); F.VB = (bf16*)(ws + WS_VB);
    F.XA = (bf16*)(ws + WS_XA); F.MIX = (bf16*)(ws + WS_MIX); F.H = (bf16*)(ws + WS_H);
    F.Dm = (float*)(ws + WS_D); F.X1 = (float*)(ws + WS_X1); F.X2 = (float*)(ws + WS_X2); F.REC = (float*)(ws + WS_REC); F.Z = (float*)(ws + WS_Z); F.GU = (float*)(ws + WS_GU); F.HL = (float*)(ws + WS_HL); F.HD = (float*)(ws + WS_HD); F.HQ = (bf16*)(ws + WS_HQ); F.HF = (float*)(ws + WS_HF); F.QS = (float*)(ws + WS_QS);
    F.XA2 = (bf16*)(ws + WS_XA2); F.XA3 = (bf16*)(ws + WS_XA3); F.D2 = (float*)(ws + WS_D2); F.D3 = (float*)(ws + WS_D3); F.H2 = (bf16*)(ws + WS_H2); F.GU2 = (float*)(ws + WS_GU2); F.SS0 = (float*)(ws + WS_SS0); F.SS1 = (float*)(ws + WS_SS1); F.SS2 = (float*)(ws + WS_SS2); F.HV = (bf16*)(ws + WS_HV); F.HG = (bf16*)(ws + WS_HG);
    F.PO = (bf16*)(ws + WS_PO); F.PM = (float*)(ws + WS_PM); F.PL = (float*)(ws + WS_PL); F.LST = (int*)(ws + WS_LST); F.CNT = (int*)(ws + WS_CNT); F.TABG = (float*)(ws + WS_TABG);
    for (int u = F.tid; u < (LDS_BYTES - LDSCTL_OFF) / 4; u += NWAVES * 64) ((LAS unsigned*)(F.lds + LDSCTL_OFF))[u] = 0u;
    __syncthreads();
    const int lo = args.ph_lo, hi = args.ph_hi;
    XcdBarrier bar; bar.bar = (unsigned*)(F.ctl + CW_BAR); bar.x = 0; bar.st = nullptr;
    if (hi - lo > 1) bar = xcd_barrier_post((unsigned*)(F.ctl + CW_BAR), F.MISC + 8);
#define IN(k) (lo <= (k) && (k) < hi)
#define SEAM(k) do { if (IN(k) && IN((k) + 1)) xcd_barrier(bar); } while (0)
#define GEMM_PHASE(EPI, E_, Abuf, Wbuf, M_, N_, K_) do { pg8::Gemm g{Abuf, Wbuf, M_, N_, K_}; pg8::StaticOrder S; S.init(M_, N_, F.G, (int)blockIdx.x); \
        pg8::gemm_phase<EPI, pg8::StaticOrder, true, true>(F.lds + RING_OFF, g, S, E_); } while (0)
    if (IN(0)) { p0_prologue(F); p0_tabg(F); } SEAM(0);
    const LAS float* srs = (const LAS float*)(F.lds + SRS_OFF);
    if (IN(1)) { pg8::EpiSwiglu E{F.H, FF, pg8::RowRs{F.SS0, 1, nullptr, MP}}; GEMM_PHASE(pg8::EpiSwiglu, E, F.XA, F.Wgu1, M_ALL, NGU, D); kms_queue(F, CW_Q1, 0, 448); } SEAM(1);
    if (IN(2)) { pg8::EpiResid<false> E{F.xp, nullptr, F.XA2, F.SS1, 0.5f}; GEMM_PHASE(pg8::EpiResid<false>, E, F.H, F.Wd1, MP, D, FF);
                 small_gemm<FF>(F, F.H + (size_t)MP * FF, F.Wd1, F.xs, F.X1 + (size_t)MP * D, F.XA2 + (size_t)MP * D, 0.5f); } SEAM(2);
    if (IN(3)) { sample_rs_to_lds(F, F.X1 + (size_t)MP * D);
                 pg8::EpiProj E{pg8::RowRs{F.SS1, 16, srs, MP}, F.qn, F.kn, F.lb, F.QB, F.KB, F.VB, F.QS, F.out + OFF_KP, F.out + OFF_KS, F.out + OFF_VP, F.out + OFF_VS, F.kmP, F.HQ, F.HF, F.HV, F.HG, MP, MR, moba::C2};
                 GEMM_PHASE(pg8::EpiProj, E, F.XA2, F.Win, M_ALL, NIN, D); kms_queue(F, CW_Q3, 448, 576); } SEAM(3);
    if (IN(4)) { hgrn_prompt_phase1(F); moba_select_phase(F); } SEAM(4);
    if (IN(5)) { ph_mixers<0>(F); } SEAM(5);
    if (IN(6)) { ph_mixers<1>(F); } SEAM(6);
    if (IN(7)) { pg8::EpiResid<true> E{F.XA2, nullptr, F.XA3, F.SS2, 1.0f}; GEMM_PHASE(pg8::EpiResid<true>, E, F.MIX, F.Wout, MP, D, D);
                 small_gemm<D>(F, F.MIX + (size_t)MP * D, F.Wout, F.X1 + (size_t)MP * D, F.X2 + (size_t)MP * D, F.XA3 + (size_t)MP * D, 1.0f); } SEAM(7);
    if (IN(8)) { sample_rs_to_lds(F, F.X2 + (size_t)MP * D); pg8::EpiSwiglu E{F.H2, FF, pg8::RowRs{F.SS2, 16, srs, MP}}; GEMM_PHASE(pg8::EpiSwiglu, E, F.XA3, F.Wgu2, M_ALL, NGU, D); } SEAM(8);
    if (IN(9)) { pg8::EpiResid<true> E{F.XA3, F.out + OFF_YP, nullptr, nullptr, 0.5f}; GEMM_PHASE(pg8::EpiResid<true>, E, F.H2, F.Wd2, MP, D, FF);
                  small_gemm<FF>(F, F.H2 + (size_t)MP * FF, F.Wd2, F.X2 + (size_t)MP * D, F.out + OFF_YS, nullptr, 0.5f); }
#undef IN
#undef SEAM
#undef GEMM_PHASE
}

#ifndef MK_N_LAUNCHES
#define MK_N_LAUNCHES 1
#endif
extern "C" void kernel_launch(void* const* d_in, const int* in_sizes, int n_in, void* d_out, int out_size, void* d_ws, size_t ws_size, hipStream_t stream) {
    static int grid = 0;
    if (grid == 0) {
        if (n_in != 22 || out_size != (int)OUT_TOTAL || ws_size < WS_END) { fprintf(stderr, "kernel_launch: unexpected shapes (n_in %d, out %d, ws %zu); nothing launched\n", n_in, out_size, ws_size); grid = -1; return; }
        int dev = 0, cus = 0;
        if (hipGetDevice(&dev) != hipSuccess || hipDeviceGetAttribute(&cus, hipDeviceAttributeMultiprocessorCount, dev) != hipSuccess) { grid = -1; return; }
        if (hipFuncSetAttribute((const void*)mk_fwd, hipFuncAttributeMaxDynamicSharedMemorySize, LDS_BYTES) != hipSuccess) { fprintf(stderr, "kernel_launch: hipFuncSetAttribute failed\n"); grid = -1; return; }
        (void)hipGetLastError();
        grid = cus;
    }
    if (grid < 0) return;
    if (hipMemsetAsync((char*)d_ws + WS_CTL, 0, CTL_ZERO_BYTES, stream) != hipSuccess) return;
    Args a{};
    for (int i = 0; i < 22; ++i) a.in[i] = d_in[i];
    a.out = (float*)d_out; a.ws = (unsigned char*)d_ws;
    if (MK_N_LAUNCHES == 1) { a.ph_lo = 0; a.ph_hi = NPHASE; hipLaunchKernelGGL(mk_fwd, dim3(grid), dim3(NWAVES * 64), LDS_BYTES, stream, a); }
    else for (int p = 0; p < NPHASE; ++p) { a.ph_lo = p; a.ph_hi = p + 1; hipLaunchKernelGGL(mk_fwd, dim3(grid), dim3(NWAVES * 64), LDS_BYTES, stream, a); }
}
```

```cpp
#include <hip/hip_runtime.h>
#include <cstdio>
#include <cstdint>
namespace pg8 {
#define PG8_LAS __attribute__((address_space(3)))
typedef unsigned short bf16_t;
typedef short bf16x8 __attribute__((ext_vector_type(8)));
typedef float f32x4 __attribute__((ext_vector_type(4)));
typedef unsigned u32x4 __attribute__((ext_vector_type(4)));
constexpr int BM = 256, BK = 64, HALF = 128, HTB = HALF * BK * 2  , STAGE_BYTES = 8 * HTB, NXCD = 8, WGM = 8;

__host__ __device__ __forceinline__ int lds_byte(int r, int c) { const int st = (r >> 4) * 2 + (c >> 5), rr = r & 15, cc = c & 31, ob = rr * 64 + cc * 2; return st * 1024 + (ob ^ (((ob >> 9) & 1) << 5)); }
__host__ __device__ __forceinline__ void stage_rc(int b, int& R, int& C) { const int st = b / 1024, sb = b % 1024, swz = sb ^ (((sb >> 9) & 1) << 5); R = (st >> 1) * 16 + swz / 64; C = (st & 1) * 32 + (swz % 64) / 2; }
__host__ __device__ __forceinline__ int perm32(int rho) { const int n = rho >> 4, i = rho & 15; return 8 * (i >> 2) + 4 * n + (i & 3); }

struct Unit { int pm, pn; };
struct Gemm { const bf16_t* A; const bf16_t* Bt; int M, N, K; };

struct StaticOrder {
    int nM, nN, nwg, G, c;
    __host__ __device__ void init(int M, int N, int G_, int c_) { nM = M / BM; nN = N / BM; nwg = nM * nN; G = G_; c = c_; }
    __host__ __device__ bool next(int i, Unit& u) const {
        const long L = (long)i * G + c; if (L >= nwg) return false;
        int wgid = (int)L; { const int q = nwg / NXCD, r = nwg % NXCD, xcd = wgid % NXCD, off = wgid / NXCD; wgid = (xcd < r ? xcd * (q + 1) : r * (q + 1) + (xcd - r) * q) + off; }
        const int nig = WGM * nN, gid = wgid / nig, fm = gid * WGM, gsz = (nM - fm) < WGM ? (nM - fm) : WGM;
        u.pm = fm + ((wgid % nig) % gsz); u.pn = (wgid % nig) / gsz; return true;
    }
    __device__ __forceinline__ void a_ready(const Unit&) const {}
    __device__ __forceinline__ void done(const Unit&) const {}
};

__device__ __forceinline__ unsigned cvt_pk_bf16(float lo, float hi) { unsigned r; asm volatile("v_cvt_pk_bf16_f32 %0, %1, %2" : "=v"(r) : "v"(lo), "v"(hi)); return r; }
typedef float f32x2 __attribute__((ext_vector_type(2)));
constexpr int SS_STRIDE = 16640;
struct RowRs {
    const float* ss; int np; const PG8_LAS float* tab; int mp;
    __device__ __forceinline__ float get(int row) const {
        if (tab && row >= mp) return tab[row - mp];
        float s;
        if (np == 16) { const f32x4* p4 = (const f32x4*)(ss + (size_t)row * 16); const f32x4 a = p4[0], b = p4[1], c = p4[2], d = p4[3]; s = ((a[0] + a[1]) + (a[2] + a[3])) + ((b[0] + b[1]) + (b[2] + b[3])) + (((c[0] + c[1]) + (c[2] + c[3])) + ((d[0] + d[1]) + (d[2] + d[3]))); }
        else s = ss[row];
        return 1.f / sqrtf(s * (1.f / 1024.f) + 1e-6f); }
};
__device__ __forceinline__ float silu_fast(float x) { return x * __builtin_amdgcn_rcpf(1.f + __expf(-x)); }
struct EpiSwiglu {
    static constexpr bool PERM = true, AFTER_DRAIN = false;
    bf16_t* H; int ldh; RowRs R;
    __device__ __forceinline__ void operator()(const f32x4 (&acc)[2][2][4][2], const Unit& u, int wr, int wc, int fr, int fq) const {
        const int row0 = u.pm * BM + wr * 64 + fr, hcol = u.pn * HALF + wc * 32 + 8 * fq;
#pragma unroll
        for (int ai = 0; ai < 2; ++ai)
#pragma unroll
            for (int m = 0; m < 4; ++m) { const int row = row0 + ai * HALF + m * 16; const float rs = R.get(row);
                const f32x4 g0 = acc[ai][0][m][0] * rs, g1 = acc[ai][0][m][1] * rs, u0 = acc[ai][1][m][0] * rs, u1 = acc[ai][1][m][1] * rs;
                u32x4 w; w.x = cvt_pk_bf16(silu_fast(g0[0]) * u0[0], silu_fast(g0[1]) * u0[1]); w.y = cvt_pk_bf16(silu_fast(g0[2]) * u0[2], silu_fast(g0[3]) * u0[3]);
                w.z = cvt_pk_bf16(silu_fast(g1[0]) * u1[0], silu_fast(g1[1]) * u1[1]); w.w = cvt_pk_bf16(silu_fast(g1[2]) * u1[2], silu_fast(g1[3]) * u1[3]);
                *(u32x4*)(H + (size_t)row * ldh + hcol) = w; }
    }
};
struct EpiF32Rs {
    static constexpr bool PERM = true, AFTER_DRAIN = false;
    float* O; int ldc; RowRs R;
    __device__ __forceinline__ void operator()(const f32x4 (&acc)[2][2][4][2], const Unit& u, int wr, int wc, int fr, int fq) const {
        const int row0 = u.pm * BM + wr * 64 + fr, col0 = u.pn * BM + wc * 64 + 8 * fq;
#pragma unroll
        for (int ai = 0; ai < 2; ++ai)
#pragma unroll
            for (int m = 0; m < 4; ++m) { const int row = row0 + ai * HALF + m * 16; const float rs = R.get(row); float* rowp = O + (size_t)row * ldc + col0;
#pragma unroll
                for (int bj = 0; bj < 2; ++bj) { *(f32x4*)(rowp + 32 * bj) = acc[ai][bj][m][0] * rs; *(f32x4*)(rowp + 32 * bj + 4) = acc[ai][bj][m][1] * rs; } }
    }
};
template <bool BB>
struct EpiResid {
    static constexpr bool PERM = true, AFTER_DRAIN = false;
    const void* bp; float* op; bf16_t* xa; float* sso; float sc;
    __device__ __forceinline__ void operator()(const f32x4 (&acc)[2][2][4][2], const Unit& u, int wr, int wc, int fr, int fq) const {
        const int row0 = u.pm * BM + wr * 64 + fr, col0 = u.pn * BM + wc * 64 + 8 * fq;
#pragma unroll
        for (int ai = 0; ai < 2; ++ai) {
            f32x4 bv[4][2][2];
#pragma unroll
            for (int m = 0; m < 4; ++m) { const size_t off = (size_t)(row0 + ai * HALF + m * 16) * 1024 + col0;
#pragma unroll
                for (int bj = 0; bj < 2; ++bj) {
                    if (BB) { const u32x4 w = *(const u32x4*)((const bf16_t*)bp + off + 32 * bj);
                        bv[m][bj][0] = (f32x4){__uint_as_float(w.x << 16), __uint_as_float(w.x & 0xffff0000u), __uint_as_float(w.y << 16), __uint_as_float(w.y & 0xffff0000u)};
                        bv[m][bj][1] = (f32x4){__uint_as_float(w.z << 16), __uint_as_float(w.z & 0xffff0000u), __uint_as_float(w.w << 16), __uint_as_float(w.w & 0xffff0000u)}; }
                    else { const float* b = (const float*)bp + off + 32 * bj; bv[m][bj][0] = *(const f32x4*)b; bv[m][bj][1] = *(const f32x4*)(b + 4); } } }
#pragma unroll
            for (int m = 0; m < 4; ++m) { const int row = row0 + ai * HALF + m * 16; const size_t off = (size_t)row * 1024 + col0; float ssq = 0.f;
#pragma unroll
                for (int bj = 0; bj < 2; ++bj) {
                    const f32x4 v0 = bv[m][bj][0] + acc[ai][bj][m][0] * sc, v1 = bv[m][bj][1] + acc[ai][bj][m][1] * sc;
                    if (op) { *(f32x4*)(op + off + 32 * bj) = v0; *(f32x4*)(op + off + 32 * bj + 4) = v1; }
                    ssq += (v0[0] * v0[0] + v0[1] * v0[1]) + (v0[2] * v0[2] + v0[3] * v0[3]) + (v1[0] * v1[0] + v1[1] * v1[1]) + (v1[2] * v1[2] + v1[3] * v1[3]);
                    if (xa) { u32x4 w; w.x = cvt_pk_bf16(v0[0], v0[1]); w.y = cvt_pk_bf16(v0[2], v0[3]); w.z = cvt_pk_bf16(v1[0], v1[1]); w.w = cvt_pk_bf16(v1[2], v1[3]); *(u32x4*)(xa + off + 32 * bj) = w; } }
                ssq += __shfl_xor(ssq, 16); ssq += __shfl_xor(ssq, 32);
                if (sso && fq == 0) sso[(size_t)row * 16 + 4 * u.pn + wc] = ssq; }
        }
    }
};
struct EpiProj {
    static constexpr bool PERM = true, AFTER_DRAIN = false;
    RowRs R; const float *qg, *kg, *lb;
    bf16_t *QB, *KB, *VB; float* QS;
    float *kp, *ks, *vp, *vs;
    float* kmP;
    bf16_t *HQ; float* HF; bf16_t *HV, *HG;
    int mp, mr; float c2;
    __device__ __forceinline__ void st8(float* p, const f32x4& a, const f32x4& b) const { *(f32x4*)p = a; *(f32x4*)(p + 4) = b; }
    __device__ __forceinline__ void st8b(bf16_t* p, const f32x4& a, const f32x4& b, float s) const { u32x4 w; w.x = cvt_pk_bf16(a[0] * s, a[1] * s); w.y = cvt_pk_bf16(a[2] * s, a[3] * s); w.z = cvt_pk_bf16(b[0] * s, b[1] * s); w.w = cvt_pk_bf16(b[2] * s, b[3] * s); *(u32x4*)p = w; }
    __device__ __forceinline__ void operator()(const f32x4 (&acc)[2][2][4][2], const Unit& u, int wr, int wc, int fr, int fq) const {
        const int type = u.pn >> 1, cb = 256 * (u.pn & 1) + 64 * wc, row0 = u.pm * BM + wr * 64 + fr, d0 = 8 * fq;
        f32x4 gn[2][2], cs[2][2];
#pragma unroll
        for (int bj = 0; bj < 2; ++bj)
#pragma unroll
            for (int n = 0; n < 2; ++n) { cs[bj][n] = (f32x4){0.f, 0.f, 0.f, 0.f}; gn[bj][n] = (f32x4){1.f, 1.f, 1.f, 1.f};
                if (type <= 1) gn[bj][n] = *(const f32x4*)((type == 0 ? qg : kg) + 32 * bj + d0 + 4 * n);
                if (type == 4) gn[bj][n] = *(const f32x4*)(lb + cb + 32 * bj + d0 + 4 * n); }
#pragma unroll
        for (int ai = 0; ai < 2; ++ai)
#pragma unroll
            for (int m = 0; m < 4; ++m) { const int row = row0 + ai * HALF + m * 16;
                if (row < mr) {
                    const float rs = R.get(row); f32x4 v[2][2];
#pragma unroll
                    for (int bj = 0; bj < 2; ++bj)
#pragma unroll
                        for (int n = 0; n < 2; ++n) v[bj][n] = acc[ai][bj][m][n] * rs;
                    const size_t o = (size_t)row * 512 + cb + d0, os = (size_t)(row - mp) * 512 + cb + d0;
                    if (type <= 1) {
                        float ss = 0.f;
#pragma unroll
                        for (int bj = 0; bj < 2; ++bj)
#pragma unroll
                            for (int n = 0; n < 2; ++n) ss += (v[bj][n][0] * v[bj][n][0] + v[bj][n][1] * v[bj][n][1]) + (v[bj][n][2] * v[bj][n][2] + v[bj][n][3] * v[bj][n][3]);
                        ss += __shfl_xor(ss, 16); ss += __shfl_xor(ss, 32);
                        const float rn = 1.f / sqrtf(ss * (1.f / 64.f) + 1e-6f);
#pragma unroll
                        for (int bj = 0; bj < 2; ++bj)
#pragma unroll
                            for (int n = 0; n < 2; ++n) v[bj][n] = v[bj][n] * rn * gn[bj][n];
                    }
                    if (type == 0) {
                        if (row < mp) { st8b(QB + o, v[0][0], v[0][1], c2); st8b(QB + o + 32, v[1][0], v[1][1], c2); } else { st8(QS + os, v[0][0], v[0][1]); st8(QS + os + 32, v[1][0], v[1][1]); }
                    } else if (type == 1) {
                        if (row < mp) { st8(kp + o, v[0][0], v[0][1]); st8(kp + o + 32, v[1][0], v[1][1]); st8b(KB + o, v[0][0], v[0][1], 1.f); st8b(KB + o + 32, v[1][0], v[1][1], 1.f);
                            cs[0][0] += v[0][0]; cs[0][1] += v[0][1]; cs[1][0] += v[1][0]; cs[1][1] += v[1][1]; }
                        else { st8(ks + os, v[0][0], v[0][1]); st8(ks + os + 32, v[1][0], v[1][1]); }
                    } else if (type == 2) {
                        if (row < mp) { st8(vp + o, v[0][0], v[0][1]); st8(vp + o + 32, v[1][0], v[1][1]); st8b(VB + o, v[0][0], v[0][1], 1.f); st8b(VB + o + 32, v[1][0], v[1][1], 1.f); }
                        else { st8(vs + os, v[0][0], v[0][1]); st8(vs + os + 32, v[1][0], v[1][1]); }
                    } else if (type == 5) { st8b(HV + o, v[0][0], v[0][1], 1.f); st8b(HV + o + 32, v[1][0], v[1][1], 1.f);
                    } else {
#pragma unroll
                        for (int bj = 0; bj < 2; ++bj)
#pragma unroll
                            for (int n = 0; n < 2; ++n)
#pragma unroll
                                for (int j = 0; j < 4; ++j) { const float z = v[bj][n][j];
                                    if (type == 4) { const float lbv = gn[bj][n][j]; v[bj][n][j] = __logf(lbv + (1.f - lbv) * __builtin_amdgcn_rcpf(1.f + __expf(-z))); } else v[bj][n][j] = silu_fast(z); }
                        if (type == 4) { st8(HF + o, v[0][0], v[0][1]); st8(HF + o + 32, v[1][0], v[1][1]); }
                        else { bf16_t* dst = (type == 3 ? HQ : HG) + o; st8b(dst, v[0][0], v[0][1], 1.f); st8b(dst + 32, v[1][0], v[1][1], 1.f); }
                    }
                } }
        if (type == 1 && u.pm * BM < mp) {
#pragma unroll
            for (int bj = 0; bj < 2; ++bj)
#pragma unroll
                for (int n = 0; n < 2; ++n)
#pragma unroll
                    for (int j = 0; j < 4; ++j) { float s = cs[bj][n][j]; s += __shfl_xor(s, 1); s += __shfl_xor(s, 2); s += __shfl_xor(s, 4); s += __shfl_xor(s, 8);
                        if (fr == 0) __hip_atomic_fetch_add(kmP + (size_t)u.pm * 512 + cb + 32 * bj + d0 + 4 * n + j, s * (1.f / 256.f), __ATOMIC_RELAXED, __HIP_MEMORY_SCOPE_AGENT); }
        }
    }
};
__device__ __forceinline__ void pg8_mfma_tied(f32x4& c, const bf16x8& a, const bf16x8& b) { asm volatile("v_mfma_f32_16x16x32_bf16 %0, %1, %2, %0" : "+v"(c) : "v"(a), "v"(b)); }
template <class Epi, class Sched, bool ALIGN_EPI = false, bool SP2 = false>
__device__ __forceinline__ void gemm_phase(PG8_LAS unsigned char* lds, const Gemm g, const Sched& S, const Epi& E) {
    const int tid = threadIdx.x, wid = __builtin_amdgcn_readfirstlane(tid >> 6), lane = tid & 63, wr = wid >> 2, wc = wid & 3, fr = lane & 15, fq = lane >> 4;
    const int K = g.K, nt = K / BK;
    unsigned voffA[2], voffB[2];
#pragma unroll
    for (int i = 0; i < 2; ++i) { int R, C; stage_rc(tid * 16 + i * 8192, R, C); const int Rb = Epi::PERM ? ((R & ~31) + perm32(R & 31)) : R;
        voffA[i] = (unsigned)(R * K + C) * 2u; voffB[i] = (unsigned)(Rb * K + C) * 2u; }
    const size_t kstep = (size_t)(BK * 2);
    const size_t hstep = (size_t)HALF * K * 2;
    const size_t tstep = 2 * hstep;
    const unsigned ldsw = (unsigned)wid * 1024u;
    const int aoff = lds_byte(wr * 64 + fr, fq * 8), boff = lds_byte(wc * 32 + fr, fq * 8);
#define PG8_SA(b, h) (((b) * 2 + (h)) * HTB)
#define PG8_SB(b, h) ((4 + (b) * 2 + (h)) * HTB)
#define PG8_STAGE(bufoff, gbase, voff) do { _Pragma("unroll") for (int _i = 0; _i < 2; ++_i) \
        __builtin_amdgcn_global_load_lds((const unsigned*)((const char*)(gbase) + (voff)[_i]), (PG8_LAS unsigned*)(lds + (bufoff) + ldsw + _i * 8192), 16, 0, 0); } while (0)
#define PG8_LDA(dst, b, h) do { _Pragma("unroll") for (int m = 0; m < 4; ++m) _Pragma("unroll") for (int k = 0; k < 2; ++k) dst[m][k] = *(const PG8_LAS bf16x8*)(lds + PG8_SA(b, h) + aoff + m * 2048 + k * 1024); } while (0)
#define PG8_LDB(dst, b, h) do { _Pragma("unroll") for (int n = 0; n < 2; ++n) _Pragma("unroll") for (int k = 0; k < 2; ++k) dst[n][k] = *(const PG8_LAS bf16x8*)(lds + PG8_SB(b, h) + boff + n * 2048 + k * 1024); } while (0)
#define PG8_MMA(ai, bj, At, Bt) do { __builtin_amdgcn_s_setprio(1); _Pragma("unroll") for (int m = 0; m < 4; ++m) _Pragma("unroll") for (int n = 0; n < 2; ++n) _Pragma("unroll") for (int k = 0; k < 2; ++k) \
        pg8_mfma_tied(acc[ai][bj][m][n], Bt[n][k], At[m][k]); __builtin_amdgcn_s_setprio(0); } while (0)
#define PG8_WAIT_V(n) asm volatile("s_waitcnt vmcnt(" #n ")" ::: "memory")
#define PG8_WAIT_L(n) asm volatile("s_waitcnt lgkmcnt(" #n ")" ::: "memory")
#define PG8_BAR __builtin_amdgcn_s_barrier()
#define PG8_SCHED __builtin_amdgcn_sched_barrier(0)
    Unit cur, nxt; int ui = 0;
    if (!S.next(0, cur)) return;
    f32x4 acc[2][2][4][2];
#pragma unroll
    for (int a = 0; a < 2; ++a)
#pragma unroll
        for (int b = 0; b < 2; ++b)
#pragma unroll
            for (int m = 0; m < 4; ++m)
#pragma unroll
                for (int n = 0; n < 2; ++n) acc[a][b][m][n] = (f32x4){0.f, 0.f, 0.f, 0.f};
    bf16x8 At[4][2], B0[2][2], B1[2][2];
    const char* cA = (const char*)g.A + (size_t)cur.pm * tstep; const char* cB = (const char*)g.Bt + (size_t)cur.pn * tstep;
    S.a_ready(cur);
    if constexpr (SP2) {
        PG8_STAGE(PG8_SB(0, 0), cB, voffB); PG8_STAGE(PG8_SB(0, 1), cB + hstep, voffB); PG8_STAGE(PG8_SA(0, 0), cA, voffA); PG8_STAGE(PG8_SA(0, 1), cA + hstep, voffA);
        if (wr == 1) PG8_BAR;
        PG8_WAIT_V(2); PG8_BAR;
        PG8_STAGE(PG8_SB(1, 0), cB + kstep, voffB); PG8_STAGE(PG8_SA(1, 0), cA + kstep, voffA); PG8_STAGE(PG8_SB(1, 1), cB + hstep + kstep, voffB);
        PG8_WAIT_V(6); PG8_BAR;
    } else {
        PG8_STAGE(PG8_SB(0, 0), cB, voffB); PG8_STAGE(PG8_SA(0, 0), cA, voffA); PG8_STAGE(PG8_SB(0, 1), cB + hstep, voffB); PG8_STAGE(PG8_SA(0, 1), cA + hstep, voffA);
        if (wr == 1) PG8_BAR;
        PG8_WAIT_V(4); PG8_BAR;
        PG8_STAGE(PG8_SB(1, 0), cB + kstep, voffB); PG8_STAGE(PG8_SA(1, 0), cA + kstep, voffA); PG8_STAGE(PG8_SB(1, 1), cB + hstep + kstep, voffB);
        PG8_WAIT_V(6); PG8_BAR;
    }
    for (;;) {
        const bool has_next = S.next(ui + 1, nxt);
        const char* nA = has_next ? (const char*)g.A + (size_t)nxt.pm * tstep : cA; const char* nB = has_next ? (const char*)g.Bt + (size_t)nxt.pn * tstep : cB;
        for (int t = 0; t < nt; t += 2) {
            const bool last = (t == nt - 2);
            const char* a1 = cA + (size_t)(t + 1) * kstep;
            const char* a2 = last ? nA : cA + (size_t)(t + 2) * kstep; const char* b2 = last ? nB : cB + (size_t)(t + 2) * kstep;
            const char* a3 = a2 + kstep; const char* b3 = b2 + kstep;
            if (last && has_next) S.a_ready(nxt);
            if constexpr (SP2) {
            PG8_LDB(B0, 0, 0); PG8_LDB(B1, 0, 1); PG8_SCHED; PG8_LDA(At, 0, 0); PG8_STAGE(PG8_SA(1, 1), a1 + hstep, voffA);
            PG8_WAIT_V(8); PG8_WAIT_L(0); PG8_BAR; PG8_MMA(0, 0, At, B0); PG8_MMA(0, 1, At, B1); PG8_BAR; PG8_SCHED;
            PG8_LDA(At, 0, 1); PG8_STAGE(PG8_SB(0, 0), b2, voffB); PG8_STAGE(PG8_SB(0, 1), b2 + hstep, voffB); PG8_STAGE(PG8_SA(0, 0), a2, voffA);
            PG8_WAIT_V(8); PG8_WAIT_L(0); PG8_BAR; PG8_MMA(1, 0, At, B0); PG8_MMA(1, 1, At, B1); PG8_BAR; PG8_SCHED;
            PG8_LDB(B0, 1, 0); PG8_LDB(B1, 1, 1); PG8_SCHED; PG8_LDA(At, 1, 0); PG8_STAGE(PG8_SA(0, 1), a2 + hstep, voffA);
            PG8_WAIT_V(8); PG8_WAIT_L(0); PG8_BAR; PG8_MMA(0, 0, At, B0); PG8_MMA(0, 1, At, B1); PG8_BAR; PG8_SCHED;
            PG8_LDA(At, 1, 1); PG8_STAGE(PG8_SB(1, 0), b3, voffB); PG8_STAGE(PG8_SB(1, 1), b3 + hstep, voffB); PG8_STAGE(PG8_SA(1, 0), a3, voffA);
            PG8_WAIT_V(8); PG8_WAIT_L(0); PG8_BAR; PG8_MMA(1, 0, At, B0); PG8_MMA(1, 1, At, B1); PG8_BAR; PG8_SCHED;
            } else {
            PG8_LDB(B0, 0, 0); PG8_SCHED; PG8_LDA(At, 0, 0); PG8_STAGE(PG8_SA(1, 1), a1 + hstep, voffA);
            PG8_WAIT_L(8); PG8_BAR; PG8_WAIT_L(0); PG8_MMA(0, 0, At, B0); PG8_BAR; PG8_SCHED;
            PG8_LDB(B1, 0, 1); PG8_STAGE(PG8_SB(0, 0), b2, voffB);
            PG8_BAR; PG8_WAIT_L(0); PG8_MMA(0, 1, At, B1); PG8_BAR;
            PG8_LDA(At, 0, 1); PG8_STAGE(PG8_SA(0, 0), a2, voffA);
            PG8_BAR; PG8_WAIT_L(0); PG8_MMA(1, 0, At, B0); PG8_BAR; PG8_SCHED;
            PG8_STAGE(PG8_SB(0, 1), b2 + hstep, voffB);
            PG8_WAIT_V(6); PG8_BAR; PG8_MMA(1, 1, At, B1); PG8_BAR;
            PG8_LDB(B0, 1, 0); PG8_SCHED; PG8_LDA(At, 1, 0); PG8_STAGE(PG8_SA(0, 1), a2 + hstep, voffA);
            PG8_WAIT_L(8); PG8_BAR; PG8_WAIT_L(0); PG8_MMA(0, 0, At, B0); PG8_BAR; PG8_SCHED;
            PG8_LDB(B1, 1, 1); PG8_STAGE(PG8_SB(1, 0), b3, voffB);
            PG8_BAR; PG8_WAIT_L(0); PG8_MMA(0, 1, At, B1); PG8_BAR;
            PG8_LDA(At, 1, 1); PG8_STAGE(PG8_SA(1, 0), a3, voffA);
            PG8_BAR; PG8_WAIT_L(0); PG8_MMA(1, 0, At, B0); PG8_BAR; PG8_SCHED;
            PG8_STAGE(PG8_SB(1, 1), b3 + hstep, voffB);
            PG8_WAIT_V(6); PG8_BAR; PG8_MMA(1, 1, At, B1); PG8_BAR;
            }
        }
        if constexpr (ALIGN_EPI) { if (wr == 0) PG8_BAR; }
        asm volatile("s_nop 15\n\ts_nop 15" ::: "memory");
        if constexpr (!Epi::AFTER_DRAIN) { E(acc, cur, wr, wc, fr, fq); S.done(cur); }
        if (!has_next) break;
#pragma unroll
        for (int a = 0; a < 2; ++a)
#pragma unroll
            for (int b = 0; b < 2; ++b)
#pragma unroll
                for (int m = 0; m < 4; ++m)
#pragma unroll
                    for (int n = 0; n < 2; ++n) acc[a][b][m][n] = (f32x4){0.f, 0.f, 0.f, 0.f};
        cur = nxt; cA = nA; cB = nB; ++ui;
        if constexpr (ALIGN_EPI) { if (wr == 1) PG8_BAR; }
    }
    PG8_WAIT_V(0);
    if constexpr (!ALIGN_EPI) { if (wr == 0) PG8_BAR; }
    PG8_BAR;
    if constexpr (Epi::AFTER_DRAIN) { E.fused(acc, cur, wr, wc, fr, fq, lds, wid, lane); S.done(cur); }
#undef PG8_SA
#undef PG8_SB
#undef PG8_STAGE
#undef PG8_LDA
#undef PG8_LDB
#undef PG8_MMA
#undef PG8_WAIT_V
#undef PG8_WAIT_L
#undef PG8_BAR
#undef PG8_SCHED
}
}
constexpr int NWAVES = 8;
constexpr int D = 1024, FF = 2816, NGU = 2 * FF, NIN = 3584;
constexpr int PB = 4, PT = 4096, MP = PB * PT;
constexpr int SB = 32, ST = 4, MS = SB * ST;
constexpr int MR = MP + MS;
constexpr int M_ALL = 16640;
constexpr int AH = 8, AD = 64, AW = 512;
constexpr int BH = 4, BKD = 128, BVD = 128, BW = 512;
constexpr int PAST = 8192, PAGE = 128, NPG = 64, MOBA = 256, NBS = PAST / MOBA  , NBP = PT / MOBA  ;
constexpr float EPS = 1e-6f;
constexpr int ZQ = 0, ZK = 512, ZV = 1024, ZQB = 1536, ZFB = 2048, ZIB = 2560, ZGB = 3072;
constexpr size_t OFF_YP = 0, OFF_YS = 16777216, OFF_KP = 16908288, OFF_VP = 25296896, OFF_SP = 33685504, OFF_KS = 33947648, OFF_VS = 34013184, OFF_SS = 34078720, OUT_TOTAL = 36175872;
constexpr size_t MiB = 1u << 20;
constexpr size_t WS_CTL = 0, CTL_ZERO_BYTES = 1 * MiB;
constexpr size_t WS_SMALL = 1 * MiB;
constexpr size_t WS_KMS = 2 * MiB;
constexpr size_t WS_WGU1 = 4 * MiB, WS_WD1 = 15 * MiB, WS_WIN = 21 * MiB, WS_WOUT = 28 * MiB, WS_WGU2 = 30 * MiB, WS_WD2 = 41 * MiB;
constexpr size_t WS_XA = 48 * MiB, WS_MIX = 81 * MiB, WS_H = 114 * MiB, WS_D = 204 * MiB, WS_X1 = 270 * MiB, WS_X2 = 336 * MiB, WS_REC = 402 * MiB, WS_Z = 436 * MiB, WS_GU = 664 * MiB, WS_QB = 1024 * MiB, WS_KB = 1040 * MiB, WS_VB = 1056 * MiB, WS_HL = 1072 * MiB, WS_HD = 1088 * MiB, WS_HQ = 1090 * MiB, WS_HF = 1124 * MiB, WS_QS = 1158 * MiB, WS_XA2 = 1160 * MiB, WS_XA3 = 1194 * MiB, WS_D2 = 1228 * MiB, WS_D3 = 1294 * MiB, WS_H2 = 1360 * MiB, WS_GU2 = 1452 * MiB, WS_SS0 = 1812 * MiB, WS_SS1 = 1814 * MiB, WS_SS2 = 1816 * MiB, WS_HV = 1818 * MiB, WS_HG = 1852 * MiB, WS_PO = 1886 * MiB, WS_PM = 1934 * MiB, WS_PL = 1936 * MiB, WS_LST = 1938 * MiB, WS_CNT = 1946 * MiB, WS_TABG = 1947 * MiB, WS_END = 1948 * MiB;
static_assert(WS_WD2 + (size_t)D * FF * 2 <= WS_XA && WS_XA + (size_t)M_ALL * D * 2 <= WS_MIX && WS_MIX + (size_t)M_ALL * D * 2 <= WS_H && WS_H + (size_t)M_ALL * FF * 2 <= WS_D &&
              WS_D + (size_t)M_ALL * D * 4 <= WS_X1 && WS_X1 + (size_t)M_ALL * D * 4 <= WS_X2 && WS_X2 + (size_t)M_ALL * D * 4 <= WS_REC && WS_REC + (size_t)M_ALL * BW * 4 <= WS_Z &&
              WS_Z + (size_t)M_ALL * NIN * 4 <= WS_GU && WS_GU + (size_t)M_ALL * NGU * 4 <= WS_QB && WS_QB + (size_t)MP * AW * 2 <= WS_KB && WS_VB + (size_t)MP * AW * 2 <= WS_END, "d_ws map");
constexpr int CW_TMO = 0, CW_CODE = 1, CW_BAR = 4096;
constexpr int RING_OFF = 0, RING_BYTES = 131072, LDSCTL_OFF = RING_BYTES, MISC_OFF = LDSCTL_OFF + 320, LDS_BYTES = 147456;
static_assert(MISC_OFF + 128 <= LDS_BYTES, "LDS map");
#include <hip/hip_bf16.h>
#include <cmath>
namespace moba {
using bf16h=__hip_bfloat16;
using bf16x8=__attribute__((ext_vector_type(8)))short;
using s16x4=__attribute__((ext_vector_type(4)))short;
using f32x16=__attribute__((ext_vector_type(16)))float;
using u32x4=__attribute__((ext_vector_type(4)))unsigned;
constexpr int BATCH=4,NHEAD=8,SEQ=4096,D=64;
constexpr int QP=512,KP=512,VP=512,OP=1024;
constexpr int NW=8,QBLK=32,QB=QBLK*NW,KVBLK=64,NQB=SEQ/QB;
__device__ __forceinline__ int crow(int r,int hi){return (r&3)+8*(r>>2)+4*hi;}
#define SBAR() __builtin_amdgcn_sched_barrier(0)
#define MLAS __attribute__((address_space(3)))
__device__ __forceinline__ void cmask(f32x16&p0,f32x16&p1,int lim){
  const float NEG=-INFINITY;
  #pragma unroll
  for(int r=0;r<16;++r){const int c=(r&3)+8*(r>>2); if(c>lim)p0[r]=NEG; if(c+32>lim)p1[r]=NEG;}
}
constexpr int NSLOT=3, NSLOTA=4, SLOTB=8192;
constexpr int LDS_K=0, LDS_V=NSLOTA*SLOTB, LDS_WS=2*NSLOTA*SLOTB, LDS_TAB=LDS_WS+NW*64*4, TAB_N=4096, LDS_OST=LDS_TAB+TAB_N*4, LDS_BYTES=LDS_OST+NW*4096;
constexpr float LOG2E=1.4426950408889634f;
constexpr float C2=0.125f*LOG2E;
__device__ __forceinline__ void glds16(const void*gsrc,unsigned lds_dst){unsigned keep;
  asm volatile("s_mov_b32 %0, m0\n\ts_mov_b32 m0, %2\n\ts_nop 0\n\tglobal_load_lds_dwordx4 %1, off\n\ts_mov_b32 m0, %0":"=&s"(keep):"v"(gsrc),"s"(lds_dst):"memory");}
__device__ __forceinline__ float max3f(float a,float b,float c){float r;asm("v_max3_f32 %0, %1, %2, %3":"=v"(r):"v"(a),"v"(b),"v"(c));return r;}
__device__ __forceinline__ float max2f(float a,float b){float r;asm("v_max_f32_e32 %0, %1, %2":"=v"(r):"v"(a),"v"(b));return r;}
__device__ __forceinline__ float fadd_s(float a,float b){float r;asm("v_add_f32_e32 %0, %1, %2":"=v"(r):"v"(a),"v"(b));return r;}
__device__ __forceinline__ float fsub_s(float a,float b){float r;asm("v_sub_f32_e32 %0, %1, %2":"=v"(r):"v"(a),"v"(b));return r;}
typedef float f32x2_t __attribute__((ext_vector_type(2))); typedef float f32x4_t __attribute__((ext_vector_type(4))); typedef __bf16 bf16x2_t __attribute__((ext_vector_type(2)));
__device__ __forceinline__ unsigned cvtpk_s(float lo,float hi){f32x2_t v={lo,hi};bf16x2_t b=__builtin_convertvector(v,bf16x2_t);return __builtin_bit_cast(unsigned,b);}
#define WAIT_BAR(N) asm volatile("s_waitcnt vmcnt(" #N ") lgkmcnt(0)\n\ts_barrier":::"memory")
typedef MLAS const char* lds_cptr;
typedef short v4i16_t __attribute__((ext_vector_type(4)));
__device__ __forceinline__ void qkt(f32x16&p0,f32x16&p1,const char*Kslot,const bf16x8*qr,int r32,int hi){
  const char*kb=Kslot+hi*1024+r32*16;
  #pragma unroll
  for(int d0=0;d0<4;++d0){
    const bf16x8 b0=*reinterpret_cast<const bf16x8*>(kb+d0*2048);
    const bf16x8 b1=*reinterpret_cast<const bf16x8*>(kb+d0*2048+512);
    p0=__builtin_amdgcn_mfma_f32_32x32x16_bf16(b0,qr[d0],p0,0,0,0);p1=__builtin_amdgcn_mfma_f32_32x32x16_bf16(b1,qr[d0],p1,0,0,0);}
}
__device__ __forceinline__ void kload8(bf16x8*kf,lds_cptr kp){
  kf[0]=*(const MLAS bf16x8*)(kp);      kf[1]=*(const MLAS bf16x8*)(kp+512);
  kf[2]=*(const MLAS bf16x8*)(kp+2048); kf[3]=*(const MLAS bf16x8*)(kp+2560);
  kf[4]=*(const MLAS bf16x8*)(kp+4096); kf[5]=*(const MLAS bf16x8*)(kp+4608);
  kf[6]=*(const MLAS bf16x8*)(kp+6144); kf[7]=*(const MLAS bf16x8*)(kp+6656);
}
__device__ __forceinline__ void kload2(bf16x8*kf,lds_cptr kp,int j){ kf[2*j]=*(const MLAS bf16x8*)(kp+j*2048); kf[2*j+1]=*(const MLAS bf16x8*)(kp+j*2048+512); }
__device__ __forceinline__ s16x4 vtr(lds_cptr p){ return __builtin_bit_cast(s16x4,__builtin_amdgcn_ds_read_tr16_b64_v4i16((MLAS v4i16_t*)p)); }
__device__ __forceinline__ float rowmax(const f32x16&p0,const f32x16&p1){
  float a=max3f(p0[0],p0[1],p1[0]),b=max3f(p0[2],p0[3],p1[1]);a=max3f(a,p1[2],p1[3]);
  #pragma unroll
  for(int r=4;r<16;r+=4){a=max3f(a,p0[r],p0[r+1]);b=max3f(b,p0[r+2],p0[r+3]);a=max3f(a,p1[r],p1[r+1]);b=max3f(b,p1[r+2],p1[r+3]);}
  const float m=max2f(a,b);
  auto rr=__builtin_amdgcn_permlane32_swap(__float_as_uint(m),__float_as_uint(m),false,false);
  return max2f(__uint_as_float(rr[0]),__uint_as_float(rr[1]));
}
__device__ __forceinline__ void pv(f32x16*o,int vb,bf16x8 pa0,bf16x8 pa1,bf16x8 pa2,bf16x8 pa3){
  #pragma unroll
  for(int d0=0;d0<2;++d0){s16x4 lo[4],hi[4];
    #pragma unroll
    for(int ks=0;ks<4;++ks){
      asm volatile("ds_read_b64_tr_b16 %0,%1 offset:%c2":"=&v"(lo[ks]):"v"(vb),"i"(d0*4096+ks*1024):"memory");
      asm volatile("ds_read_b64_tr_b16 %0,%1 offset:%c2":"=&v"(hi[ks]):"v"(vb),"i"(d0*4096+ks*1024+512):"memory");}
    asm volatile("s_waitcnt lgkmcnt(0)":::"memory");SBAR();
    #define PK(k) (bf16x8){lo[k][0],lo[k][1],lo[k][2],lo[k][3],hi[k][0],hi[k][1],hi[k][2],hi[k][3]}
    o[d0]=__builtin_amdgcn_mfma_f32_32x32x16_bf16(pa0,PK(0),o[d0],0,0,0);
    o[d0]=__builtin_amdgcn_mfma_f32_32x32x16_bf16(pa1,PK(1),o[d0],0,0,0);
    o[d0]=__builtin_amdgcn_mfma_f32_32x32x16_bf16(pa2,PK(2),o[d0],0,0,0);
    o[d0]=__builtin_amdgcn_mfma_f32_32x32x16_bf16(pa3,PK(3),o[d0],0,0,0);
    #undef PK
  }
}
#ifndef ATTN_STORE16
#define ATTN_STORE16(p,v) (*(u32x4*)(p)=(v))
#endif
template<int THRL,bool GATHER> __device__ __forceinline__ void moba_core(int b,int h,int qb,int gq,int grec,const bf16h*Q,const bf16h*__restrict__ K,const bf16h*__restrict__ V,bf16h*O,bf16h*PO,float*PM,float*PL,char*shm){
  int tid_=threadIdx.x; asm volatile("":"+v"(tid_));
  const int tid=tid_,lane=tid&63,r32=lane&31,hi=lane>>5; const int wid=__builtin_amdgcn_readfirstlane(tid>>6);
  const long rowbase=(long)b*SEQ; const int q0=qb*QB;
  const bf16h*Qw=Q+(rowbase+q0+wid*QBLK)*QP+h*D;
  const bf16h*Kh=K+rowbase*KP+h*D,*Vh=V+rowbase*VP+h*D;
  const unsigned lds0=(unsigned)(uintptr_t)shm;
  float*wsf=(float*)(shm+LDS_WS)+wid*64;
  const bf16h*ksrc=Kh+(long)lane*KP+wid*8;
  const bf16h*vsrc=Vh+(long)(16*(wid&3)+(lane>>2))*VP+(wid>>2)*32+(lane&3)*8;
  const unsigned kdst=lds0+LDS_K+wid*1024, vdst=lds0+LDS_V+wid*1024;
  #define KVROW(t) (((t)<4)?(q0+64*(t)):(64*((t)-4)))
  #define DMA_K(t,slot) glds16(ksrc+(long)KVROW(t)*KP,(unsigned)__builtin_amdgcn_readfirstlane(kdst+(slot)))
  #define DMA_V(t,slot) glds16(vsrc+(long)KVROW(t)*VP,(unsigned)__builtin_amdgcn_readfirstlane(vdst+(slot)))
  const int vb0=(int)(lds0+LDS_V)+((lane>>4)&1)*32+(lane&3)*8+(4*hi+((lane&15)>>2))*64;
  const char*Kbase=shm+LDS_K; bf16x8 kf[8];
  const lds_cptr shm3=(lds_cptr)shm; const lds_cptr kp0=shm3+LDS_K+hi*1024+r32*16; const lds_cptr vp0=shm3+LDS_V+((lane>>4)&1)*32+(lane&3)*8+(4*hi+((lane&15)>>2))*64;
  const lds_cptr tabr0=shm3+LDS_TAB+4*(TAB_N-1)+16*hi;
  constexpr int T0=GATHER?4:0;
  const int qrel=wid*QBLK+r32;
  const int qoff=GATHER?(gq-256*qb):(q0+qrel);
  if(!GATHER){DMA_K(0,0);DMA_V(0,0);DMA_K(1,SLOTB);}
  bf16x8 qr[4];
  { const bf16h*Qg=GATHER?(Q+(rowbase+gq)*QP+h*D):(Qw+(long)r32*QP);
  #pragma unroll
  for(int d0=0;d0<4;++d0)qr[d0]=*reinterpret_cast<const bf16x8*>(&Qg[d0*16+hi*8]); }
  float mhat=0.f,l_reg=0.f;f32x16 o[2];o[0]=f32x16{};o[1]=f32x16{};
  #define CR(r) (((r)&3)+8*((r)>>2))
  #define BIASLD(C0,C1,t) do{ const int tt_=(t); const int db_=(tt_<4)?(qrel-64*tt_):(qoff-64*(tt_-4)); const lds_cptr tb_=tabr0-4*db_;   \
      _Pragma("unroll") for(int r=0;r<16;++r){ C0[r]=*(const MLAS float*)(tb_+4*CR(r)); C1[r]=*(const MLAS float*)(tb_+4*(CR(r)+32)); } }while(0)
  #define CADD(C0,C1,t) do{ const float x_=-mhat; \
      _Pragma("unroll") for(int r=0;r<16;++r){ C0[r]+=x_; C1[r]+=x_; } }while(0)
  #define CINIT(C0,C1,t) do{ BIASLD(C0,C1,t); CADD(C0,C1,t); }while(0)
  #define CMASK(P0,P1,t) do{ if((t)<4)cmask(P0,P1,qrel-64*(t)-4*hi); }while(0)
  bool resc=false;
  #define START(P0,P1) do{ const float rm=rowmax(P0,P1); resc=false; \
    { const float dl=rm; mhat=fadd_s(mhat,dl); \
      _Pragma("unroll") for(int r=0;r<16;++r){P0[r]=fsub_s(P0[r],dl);P1[r]=fsub_s(P1[r],dl);} } \
    _Pragma("unroll") for(int r=0;r<16;++r)P0[r]=__builtin_amdgcn_exp2f(P0[r]); }while(0)
  #define RESC() do{ if(resc){ asm volatile("s_waitcnt lgkmcnt(0)":::"memory"); \
      _Pragma("unroll") for(int d_=0;d_<2;++d_) _Pragma("unroll") for(int r=0;r<16;++r)o[d_][r]*=wsf[crow(r,hi)]; } }while(0)
  f32x16 pA0,pA1,pB0,pB1;
  int sl_prev=0,sl_cur=0,sl_next=SLOTB;
  #define ROT() do{sl_prev=sl_cur;sl_cur=sl_next;sl_next=(sl_next==((GATHER?NSLOTA:NSLOT)-1)*SLOTB)?0:sl_next+SLOTB;}while(0)
  if(!GATHER){DMA_K(2,2*SLOTB);}
  if(!GATHER){WAIT_BAR(3);}
  CINIT(pA0,pA1,T0);
  qkt(pA0,pA1,Kbase,qr,r32,hi);asm volatile("s_nop 15\n\ts_nop 7":"+v"(pA0),"+v"(pA1));CMASK(pA0,pA1,T0);
  START(pA0,pA1);
  _Pragma("unroll") for(int r=0;r<16;++r)pA1[r]=__builtin_amdgcn_exp2f(pA1[r]);
  if(!GATHER){WAIT_BAR(0);DMA_K(3,0);DMA_V(1,SLOTB);}
  ROT();
  kload8(kf,kp0+sl_cur);
  if(!GATHER){WAIT_BAR(2);}
  s16x4 vlo[8],vhi[8]; u32x4 pw0,pw1,pw2,pw3;
  #define PKW(P,B) cvtpk_s(P[B],P[B+1])
  #define PAF(k) __builtin_bit_cast(bf16x8,pw##k)
  #define VFR(i) (bf16x8){vlo[i][0],vlo[i][1],vlo[i][2],vlo[i][3],vhi[i][0],vhi[i][1],vhi[i][2],vhi[i][3]}
  #define PIN(x) asm volatile("":"+v"(x))
  #define MX3(a,b,c) __builtin_fmaxf(__builtin_fmaxf((a),(b)),(c))
  #define GAPA(MF,A0,A1,A2,A3,W0,W1,PW) do{ MF; sacc+=A0; sacc+=A1; sacc+=A2; sacc+=A3; PIN(sacc); W0; W1; PIN(PW); SBAR(); }while(0)
  #define EX(v) __builtin_amdgcn_exp2f(v)
  #define GAPB(MF,X,B) do{ MF; X[B]=EX(X[B]); X[B+1]=EX(X[B+1]); X[B+2]=EX(X[B+2]); X[B+3]=EX(X[B+3]); PIN(X); SBAR(); }while(0)
  #define VRD(i) do{ vlo[i]=vtr(vp_+(((i)>>2)*4096+((i)&3)*1024)); vhi[i]=vtr(vp_+(((i)>>2)*4096+((i)&3)*1024+512)); }while(0)
  #define KRD(G,j) do{ if(G){ kload2(kf,kp0+sl_next,j); SBAR(); } }while(0)
  #define STEP(C0,C1,P0,P1,t,GK,GV,GL) do{ SBAR(); \
    CADD(C0,C1,t); SBAR(); \
    const lds_cptr vp_=vp0+sl_prev; \
    VRD(0); SBAR(); float sacc=(P0[0]+P0[1]); \
    GAPA(C0=__builtin_amdgcn_mfma_f32_32x32x16_bf16(kf[0],qr[0],C0,0,0,0), P0[2],P0[3],P0[4],P0[5],     pw0[0]=PKW(P0,0), pw0[1]=PKW(P0,2), pw0); \
    VRD(4); SBAR(); GAPA(C1=__builtin_amdgcn_mfma_f32_32x32x16_bf16(kf[1],qr[0],C1,0,0,0), P0[6],P0[7],P0[8],P0[9],     pw0[2]=PKW(P0,4), pw0[3]=PKW(P0,6), pw0); \
    VRD(1); SBAR(); GAPA(C0=__builtin_amdgcn_mfma_f32_32x32x16_bf16(kf[2],qr[1],C0,0,0,0),   P0[10],P0[11],P0[12],P0[13], pw1[0]=PKW(P0,8), pw1[1]=PKW(P0,10), pw1); \
    VRD(5); SBAR(); GAPA(C1=__builtin_amdgcn_mfma_f32_32x32x16_bf16(kf[3],qr[1],C1,0,0,0),   P0[14],P0[15],P1[0],P1[1],   pw1[2]=PKW(P0,12),pw1[3]=PKW(P0,14), pw1); \
    VRD(2); SBAR(); GAPA(C0=__builtin_amdgcn_mfma_f32_32x32x16_bf16(kf[4],qr[2],C0,0,0,0),   P1[2],P1[3],P1[4],P1[5],     pw2[0]=PKW(P1,0), pw2[1]=PKW(P1,2), pw2); \
    VRD(6); SBAR(); GAPA(C1=__builtin_amdgcn_mfma_f32_32x32x16_bf16(kf[5],qr[2],C1,0,0,0),   P1[6],P1[7],P1[8],P1[9],     pw2[2]=PKW(P1,4), pw2[3]=PKW(P1,6), pw2); \
    VRD(3); SBAR(); GAPA(C0=__builtin_amdgcn_mfma_f32_32x32x16_bf16(kf[6],qr[3],C0,0,0,0),   P1[10],P1[11],P1[12],P1[13], pw3[0]=PKW(P1,8), pw3[1]=PKW(P1,10), pw3); \
    VRD(7); SBAR(); GAPA(C1=__builtin_amdgcn_mfma_f32_32x32x16_bf16(kf[7],qr[3],C1,0,0,0),   P1[14],P1[15],0.f,0.f,       pw3[2]=PKW(P1,12),pw3[3]=PKW(P1,14), pw3); \
    l_reg+=sacc; \
    if(GK){DMA_K((t)+3,sl_cur);} if(GV){DMA_V((t)+1,sl_next);} \
    CMASK(C0,C1,t); \
    { float a=MX3(C0[0],C0[1],C1[0]),b=MX3(C0[2],C0[3],C1[1]); a=MX3(a,C1[2],C1[3]); \
      _Pragma("unroll") for(int r=4;r<16;r+=4){a=MX3(a,C0[r],C0[r+1]);b=MX3(b,C0[r+2],C0[r+3]);a=MX3(a,C1[r],C1[r+1]);b=MX3(b,C1[r+2],C1[r+3]);} \
      float rm=__builtin_fmaxf(a,b); { auto rr=__builtin_amdgcn_permlane32_swap(__float_as_uint(rm),__float_as_uint(rm),false,false); rm=__builtin_fmaxf(__uint_as_float(rr[0]),__uint_as_float(rr[1])); } \
      resc=false; \
      if(__builtin_expect(__any(rm>(float)THRL),0)){ const float dl=__builtin_fmaxf(rm,0.f); mhat+=dl; \
        _Pragma("unroll") for(int r=0;r<16;++r){C0[r]-=dl;C1[r]-=dl;} \
        const float f=__builtin_amdgcn_exp2f(-dl); l_reg*=f; if(hi==0)wsf[r32]=f; resc=true; } } \
    SBAR(); \
    if(GL){ BIASLD(P0,P1,(t)+1); } SBAR(); \
    GAPB(o[0]=__builtin_amdgcn_mfma_f32_32x32x16_bf16(PAF(0),VFR(0),o[0],0,0,0), C0,0); \
    GAPB(o[1]=__builtin_amdgcn_mfma_f32_32x32x16_bf16(PAF(0),VFR(4),o[1],0,0,0), C0,4); \
    KRD(GL,0); GAPB(o[0]=__builtin_amdgcn_mfma_f32_32x32x16_bf16(PAF(1),VFR(1),o[0],0,0,0), C0,8); \
    KRD(GL,1); GAPB(o[1]=__builtin_amdgcn_mfma_f32_32x32x16_bf16(PAF(1),VFR(5),o[1],0,0,0), C0,12); \
    KRD(GL,2); GAPB(o[0]=__builtin_amdgcn_mfma_f32_32x32x16_bf16(PAF(2),VFR(2),o[0],0,0,0), C1,0); \
    KRD(GL,3); GAPB(o[1]=__builtin_amdgcn_mfma_f32_32x32x16_bf16(PAF(2),VFR(6),o[1],0,0,0), C1,4); \
    GAPB(o[0]=__builtin_amdgcn_mfma_f32_32x32x16_bf16(PAF(3),VFR(3),o[0],0,0,0), C1,8); \
    GAPB(o[1]=__builtin_amdgcn_mfma_f32_32x32x16_bf16(PAF(3),VFR(7),o[1],0,0,0), C1,12); \
    }while(0)
  BIASLD(pB0,pB1,T0+1);
  if(GATHER){
    STEP(pB0,pB1,pA0,pA1,5,false,false,true);  RESC(); ROT();
    STEP(pA0,pA1,pB0,pB1,6,false,false,true);  RESC(); ROT();
    STEP(pB0,pB1,pA0,pA1,7,false,false,false); RESC();
  }else{
    STEP(pB0,pB1,pA0,pA1,1,false,true,true);   WAIT_BAR(1); RESC(); ROT();
    STEP(pA0,pA1,pB0,pB1,2,false,true,true);   WAIT_BAR(0); RESC(); ROT();
    STEP(pB0,pB1,pA0,pA1,3,false,false,false); RESC();
  }
  { float sacc=pB0[0]+pB0[1]; _Pragma("unroll") for(int r=2;r<16;++r)sacc+=pB0[r]; _Pragma("unroll") for(int r=0;r<16;++r)sacc+=pB1[r]; l_reg+=sacc;
    pw0=(u32x4){PKW(pB0,0),PKW(pB0,2),PKW(pB0,4),PKW(pB0,6)};pw1=(u32x4){PKW(pB0,8),PKW(pB0,10),PKW(pB0,12),PKW(pB0,14)};pw2=(u32x4){PKW(pB1,0),PKW(pB1,2),PKW(pB1,4),PKW(pB1,6)};pw3=(u32x4){PKW(pB1,8),PKW(pB1,10),PKW(pB1,12),PKW(pB1,14)};
    SBAR(); pv(o,vb0+sl_cur,PAF(0),PAF(1),PAF(2),PAF(3)); }
  #undef PKW
  #undef PAF
  #undef VFR
  #undef PIN
  #undef MX3
  #undef GAPA
  #undef GAPB
  #undef EX
  #undef VRD
  #undef KRD
  #undef STEP
  {auto rr=__builtin_amdgcn_permlane32_swap(__float_as_uint(l_reg),__float_as_uint(l_reg),false,false);l_reg=__uint_as_float(rr[0])+__uint_as_float(rr[1]);}
  bf16h*stg=(bf16h*)(shm+LDS_OST)+wid*2048;
  if(GATHER){
    int*wsi=(int*)wsf;
    if(hi==0){ wsi[r32]=grec; if(grec>=0){PM[grec]=mhat;PL[grec]=l_reg;} }
    #pragma unroll
    for(int r=0;r<16;++r){const int orow=crow(r,hi);
      #pragma unroll
      for(int d0=0;d0<2;++d0)stg[orow*64+d0*32+r32]=__float2bfloat16(o[d0][r]);}
    asm volatile("s_waitcnt lgkmcnt(0)":::"memory");
    #pragma unroll
    for(int i=0;i<4;++i){const int row=i*8+(lane>>3),ch=lane&7; const u32x4 v=*(const u32x4*)(stg+row*64+ch*8); const int rc=wsi[row]; if(rc>=0)ATTN_STORE16(PO+(size_t)rc*64+ch*8,v);}
    asm volatile("s_waitcnt lgkmcnt(0)":::"memory");
  }else{
    const int ns=qb<3?qb:3;
    const size_t rb0=((size_t)((b*NHEAD+h)*3)*SEQ)+(size_t)(q0+wid*QBLK);
    float pm[3],pl[3]; u32x4 prow[3][4];
    #pragma unroll
    for(int s_=0;s_<3;++s_) if(s_<ns){ const size_t rb=rb0+(size_t)s_*SEQ; pm[s_]=PM[rb+r32]; pl[s_]=PL[rb+r32];
      #pragma unroll
      for(int i=0;i<4;++i)prow[s_][i]=*(const u32x4*)(PO+(rb+(size_t)(i*8+(lane>>3)))*64+(lane&7)*8); }
    float mm=mhat;
    #pragma unroll
    for(int s_=0;s_<3;++s_) if(s_<ns)mm=__builtin_fmaxf(mm,pm[s_]);
    const float fo=__builtin_amdgcn_exp2f(mhat-mm); float lt=l_reg*fo; float fs[3];
    #pragma unroll
    for(int s_=0;s_<3;++s_) if(s_<ns){ fs[s_]=__builtin_amdgcn_exp2f(pm[s_]-mm); lt+=pl[s_]*fs[s_]; }
    if(hi==0){wsf[r32]=fo;wsf[32+r32]=lt;}
    asm volatile("s_waitcnt lgkmcnt(0)":::"memory");
    #pragma unroll
    for(int r=0;r<16;++r){ const float f_=wsf[crow(r,hi)]; o[0][r]*=f_; o[1][r]*=f_; }
    #pragma unroll
    for(int s_=0;s_<3;++s_) if(s_<ns){
      asm volatile("s_waitcnt lgkmcnt(0)":::"memory");
      if(hi==0)wsf[r32]=fs[s_];
      #pragma unroll
      for(int i=0;i<4;++i){const int row=i*8+(lane>>3),ch=lane&7; *(u32x4*)(stg+row*64+ch*8)=prow[s_][i];}
      asm volatile("s_waitcnt lgkmcnt(0)":::"memory");
      #pragma unroll
      for(int r=0;r<16;++r){const int orow=crow(r,hi); const float f_=wsf[orow];
        #pragma unroll
        for(int d0=0;d0<2;++d0)o[d0][r]+=f_*__bfloat162float(stg[orow*64+d0*32+r32]);}
    }
    asm volatile("s_waitcnt lgkmcnt(0)":::"memory");
    float rli[16];
    #pragma unroll
    for(int r=0;r<16;++r)rli[r]=__builtin_amdgcn_rcpf(wsf[32+crow(r,hi)]);
    bf16h*Ow=O+(rowbase+q0+wid*QBLK)*OP+h*D;
    #pragma unroll
    for(int r=0;r<16;++r){const int orow=crow(r,hi);
      #pragma unroll
      for(int d0=0;d0<2;++d0)stg[orow*64+d0*32+r32]=__float2bfloat16(o[d0][r]*rli[r]);}
    asm volatile("s_waitcnt lgkmcnt(0)":::"memory");
    #pragma unroll
    for(int i=0;i<4;++i){const int row=i*8+(lane>>3),ch=lane&7; const u32x4 v=*(const u32x4*)(stg+row*64+ch*8); ATTN_STORE16(Ow+(long)row*OP+ch*8,v);}
    asm volatile("s_waitcnt lgkmcnt(0)\n\ts_barrier":::"memory");
  }
  #undef DMA_K
  #undef DMA_V
  #undef KVROW
  #undef CMASK
  #undef CINIT
  #undef BIASLD
  #undef CADD
  #undef CR
  #undef START
  #undef RESC
  #undef ROT
}
constexpr int ATTN_LDS_BYTES=LDS_BYTES;
#undef SBAR
#undef WAIT_BAR
}
namespace hg {
typedef short s16x4 __attribute__((ext_vector_type(4)));
typedef short s16x8 __attribute__((ext_vector_type(8)));
typedef float f32x4 __attribute__((ext_vector_type(4)));
#define HLAS __attribute__((address_space(3)))
constexpr int ROWB = 136, IMG = 128 * ROWB, OFF_QT = 0, OFF_KT = IMG, OFF_VT = 2 * IMG, OFF_DCH = 3 * IMG, BUFB = 3 * IMG + 2048, OFF_TOT = 2 * BUFB, OFF_SSQ = 2 * BUFB + 2048, OFF_OW = OFF_SSQ + 4096, LDS_BYTES = OFF_OW + 8 * 2048;
constexpr int SC = 256, NSC = 16;
__device__ __forceinline__ unsigned pkbf(float lo, float hi) { typedef float f2 __attribute__((ext_vector_type(2))); typedef __bf16 b2 __attribute__((ext_vector_type(2))); f2 v = {lo, hi}; b2 b = __builtin_convertvector(v, b2); return __builtin_bit_cast(unsigned, b); }
__device__ __forceinline__ void mfma32_t(f32x4& c, const s16x8& a, const s16x8& b) { asm volatile("s_nop 1\n\tv_mfma_f32_16x16x32_bf16 %0, %1, %2, %0" : "+v"(c) : "v"(a), "v"(b)); }
__device__ __forceinline__ void mfma16_t(f32x4& c, const s16x4& a, const s16x4& b) { asm volatile("s_nop 1\n\tv_mfma_f32_16x16x16_bf16 %0, %1, %2, %0" : "+v"(c) : "v"(a), "v"(b)); }
template <int CTRL> __device__ __forceinline__ float dpp_f(float v) { return __builtin_bit_cast(float, __builtin_amdgcn_update_dpp(0, __builtin_bit_cast(int, v), CTRL, 0xf, 0xf, true)); }
__device__ __forceinline__ float row16_sum(float s) { s += dpp_f<0x128>(s); s += dpp_f<0x124>(s); s += dpp_f<0x122>(s); s += dpp_f<0x121>(s); return s; }
__device__ __forceinline__ s16x4 trr(const HLAS char* p) { return __builtin_bit_cast(s16x4, __builtin_amdgcn_ds_read_tr16_b64_v4i16((HLAS s16x4*)p)); }
template <bool FULL>
__device__ __forceinline__ void hgrn_unit(int b, int h, int n, const unsigned short* __restrict__ Qs, int qpitch, const float* __restrict__ Fs, int fpitch, const unsigned short* __restrict__ Vs, int vpitch, const unsigned short* __restrict__ Gs, const float* __restrict__ gain, unsigned short* __restrict__ MIXo, float* __restrict__ slabL, float* __restrict__ slabD,
                                          float* __restrict__ state_out, HLAS char* lds) {
    const int tid = threadIdx.x, lane = tid & 63, x = lane & 15, g = lane >> 4; const int w = __builtin_amdgcn_readfirstlane(tid >> 6);
    const int unit = (b * 4 + h) * NSC + n; const size_t row0 = (size_t)b * 4096 + (size_t)n * SC;
    const int pk = tid & 127, pcg = tid >> 7;
    float lf[16]; unsigned vvp[8], qqp[8];
#define HG_LOADRAW(gq) do { const size_t r0_ = row0 + 64 * (gq) + 16 * pcg; const unsigned short* qr_ = Qs + r0_ * qpitch + h * 128 + pk; const float* fr_ = Fs + r0_ * fpitch + h * 128 + pk; const unsigned short* vr_ = Vs + r0_ * vpitch + h * 128 + pk; \
        _Pragma("unroll") for (int j = 0; j < 16; ++j) lf[j] = fr_[(size_t)j * fpitch]; \
        _Pragma("unroll") for (int j = 0; j < 16; j += 2) { vvp[j >> 1] = (unsigned)vr_[(size_t)j * vpitch] | ((unsigned)vr_[(size_t)(j + 1) * vpitch] << 16); if (FULL) qqp[j >> 1] = (unsigned)qr_[(size_t)j * qpitch] | ((unsigned)qr_[(size_t)(j + 1) * qpitch] << 16); } } while (0)
    f32x4 S[8];
#pragma unroll
    for (int kt = 0; kt < 8; ++kt) S[kt] = (f32x4){0.f, 0.f, 0.f, 0.f};
    if (FULL) {
        typedef unsigned u32x2 __attribute__((ext_vector_type(2)));
        HLAS f32x4* dt = (HLAS f32x4*)(lds + OFF_OW);
        for (int i = tid; i < n * 32; i += 512) dt[i] = ((const f32x4*)(slabD + (size_t)((b * 4 + h) * NSC) * 128))[i];
        __syncthreads();
        const u32x2* Lb = (const u32x2*)slabL + ((size_t)(((b * 4 + h) * NSC) * 8 + w) * 8) * 64 + lane;
#define HG_SLAB(m_) do { _Pragma("unroll") for (int kt = 0; kt < 8; ++kt) { const u32x2 l = lq[(m_) & 3][kt]; const f32x4 d = dt[(m_) * 32 + 4 * kt + g]; \
            S[kt] = S[kt] * d + (f32x4){__uint_as_float(l.x << 16), __uint_as_float(l.x & 0xffff0000u), __uint_as_float(l.y << 16), __uint_as_float(l.y & 0xffff0000u)}; } } while (0)
        int m = 0;
        for (; m + 3 < n; m += 4) { u32x2 lq[4][8];
#pragma unroll
            for (int q = 0; q < 4; ++q)
#pragma unroll
                for (int kt = 0; kt < 8; ++kt) lq[q][kt] = Lb[(size_t)(m + q) * 4096 + kt * 64];
            HG_SLAB(m); HG_SLAB(m + 1); HG_SLAB(m + 2); HG_SLAB(m + 3); }
        { u32x2 lq[4][8];
#pragma unroll
          for (int q = 0; q < 3; ++q) if (m + q < n) {
#pragma unroll
              for (int kt = 0; kt < 8; ++kt) lq[q][kt] = Lb[(size_t)(m + q) * 4096 + kt * 64]; }
          if (m < n) HG_SLAB(m);
          if (m + 1 < n) { const int m1 = m + 1; _Pragma("unroll") for (int kt = 0; kt < 8; ++kt) { const u32x2 l = lq[1][kt]; const f32x4 d = dt[m1 * 32 + 4 * kt + g]; S[kt] = S[kt] * d + (f32x4){__uint_as_float(l.x << 16), __uint_as_float(l.x & 0xffff0000u), __uint_as_float(l.y << 16), __uint_as_float(l.y & 0xffff0000u)}; } }
          if (m + 2 < n) { const int m2 = m + 2; _Pragma("unroll") for (int kt = 0; kt < 8; ++kt) { const u32x2 l = lq[2][kt]; const f32x4 d = dt[m2 * 32 + 4 * kt + g]; S[kt] = S[kt] * d + (f32x4){__uint_as_float(l.x << 16), __uint_as_float(l.x & 0xffff0000u), __uint_as_float(l.y << 16), __uint_as_float(l.y & 0xffff0000u)}; } } }
#undef HG_SLAB
    }
    HG_LOADRAW(0);
    float tsum = 0.f;
    HLAS unsigned short* const ow = (HLAS unsigned short*)(lds + OFF_OW) + w * 1024;
    const int trq0 = (4 * g + (x >> 2)) * ROWB + 8 * (x & 3), rr0 = x * ROWB + 8 * g;
    for (int grp = 0; grp < 4; ++grp) {
        HLAS char* pb = lds + (grp & 1) * BUFB;
        {
            float cum = 0.f; unsigned qp[8], kp[8], vp[8];
#pragma unroll
            for (int j = 0; j < 16; j += 2) {
                cum += lf[j];     const float e0 = __expf(cum), m0 = __expf(fminf(-cum, 80.f)), k0 = (1.f - __expf(lf[j])) * m0;
                cum += lf[j + 1]; const float e1 = __expf(cum), m1 = __expf(fminf(-cum, 80.f)), k1 = (1.f - __expf(lf[j + 1])) * m1;
                kp[j >> 1] = pkbf(k0, k1); vp[j >> 1] = vvp[j >> 1]; if (FULL) qp[j >> 1] = pkbf(__uint_as_float(qqp[j >> 1] << 16) * e0, __uint_as_float(qqp[j >> 1] & 0xffff0000u) * e1); }
            tsum += cum;
            typedef unsigned u32x2 __attribute__((ext_vector_type(2)));
            HLAS char* wr = pb + pk * ROWB + pcg * 32;
#pragma unroll
            for (int j = 0; j < 4; ++j) { *(HLAS u32x2*)(wr + OFF_KT + 8 * j) = (u32x2){kp[2 * j], kp[2 * j + 1]}; *(HLAS u32x2*)(wr + OFF_VT + 8 * j) = (u32x2){vp[2 * j], vp[2 * j + 1]};
                if (FULL) *(HLAS u32x2*)(wr + OFF_QT + 8 * j) = (u32x2){qp[2 * j], qp[2 * j + 1]}; }
            *(HLAS float*)(pb + OFF_DCH + (pcg * 128 + pk) * 4) = __expf(cum);
            if (grp < 3) HG_LOADRAW(grp + 1);
        }
        __syncthreads();
#define HG_FINALIZE(gp) do { const HLAS float* sq_ = (const HLAS float*)(lds + OFF_SSQ) + ((gp) & 1) * 512 + lane; float t_ = 0.f; \
            _Pragma("unroll") for (int w_ = 0; w_ < 8; ++w_) t_ += sq_[w_ * 64]; \
            const float rs_ = 1.f / sqrtf(t_ * (1.f / 128.f) + 1e-6f); const size_t r_ = row0 + 64 * (gp) + lane; \
            typedef unsigned u32x4_ __attribute__((ext_vector_type(4))); \
            const u32x4_ o0_ = *(const HLAS u32x4_*)(ow + lane * 16), o1_ = *(const HLAS u32x4_*)(ow + lane * 16 + 8); \
            const u32x4_ g0_ = *(const u32x4_*)(Gs + r_ * 512 + h * 128 + 16 * w), g1_ = *(const u32x4_*)(Gs + r_ * 512 + h * 128 + 16 * w + 8); \
            const float* gp_ = gain + h * 128 + 16 * w; u32x4_ y0_, y1_; \
            _Pragma("unroll") for (int j_ = 0; j_ < 4; ++j_) { \
                y0_[j_] = pkbf(__uint_as_float(o0_[j_] << 16) * rs_ * gp_[2 * j_] * __uint_as_float(g0_[j_] << 16), __uint_as_float(o0_[j_] & 0xffff0000u) * rs_ * gp_[2 * j_ + 1] * __uint_as_float(g0_[j_] & 0xffff0000u)); \
                y1_[j_] = pkbf(__uint_as_float(o1_[j_] << 16) * rs_ * gp_[8 + 2 * j_] * __uint_as_float(g1_[j_] << 16), __uint_as_float(o1_[j_] & 0xffff0000u) * rs_ * gp_[9 + 2 * j_] * __uint_as_float(g1_[j_] & 0xffff0000u)); } \
            *(u32x4_*)(MIXo + r_ * 1024 + 512 + h * 128 + 16 * w) = y0_; *(u32x4_*)(MIXo + r_ * 1024 + 512 + h * 128 + 16 * w + 8) = y1_; } while (0)
        if (FULL) { if (grp > 0) HG_FINALIZE(grp - 1); }
#pragma unroll
        for (int c = 0; c < 4; ++c) {
            const s16x4 vf = *(const HLAS s16x4*)(pb + OFF_VT + (16 * w) * ROWB + rr0 + c * 32);
            if (FULL) {
                s16x8 qf[4], kf[4];
#pragma unroll
                for (int s = 0; s < 4; ++s) {
                    const s16x4 a = trr(pb + OFF_QT + trq0 + s * 32 * ROWB + c * 32), bq = trr(pb + OFF_QT + trq0 + s * 32 * ROWB + 16 * ROWB + c * 32);
                    const s16x4 ck = trr(pb + OFF_KT + trq0 + s * 32 * ROWB + c * 32), dk = trr(pb + OFF_KT + trq0 + s * 32 * ROWB + 16 * ROWB + c * 32);
                    qf[s] = (s16x8){a[0], a[1], a[2], a[3], bq[0], bq[1], bq[2], bq[3]}; kf[s] = (s16x8){ck[0], ck[1], ck[2], ck[3], dk[0], dk[1], dk[2], dk[3]}; }
                f32x4 oacc = (f32x4){0.f, 0.f, 0.f, 0.f}, sc = (f32x4){0.f, 0.f, 0.f, 0.f};
#pragma unroll
                for (int s = 0; s < 4; ++s) {
                    typedef unsigned u32x4 __attribute__((ext_vector_type(4)));
                    const u32x4 sp = (u32x4){pkbf(S[2 * s][0], S[2 * s][1]), pkbf(S[2 * s][2], S[2 * s][3]), pkbf(S[2 * s + 1][0], S[2 * s + 1][1]), pkbf(S[2 * s + 1][2], S[2 * s + 1][3])};
                    mfma32_t(oacc, qf[s], __builtin_bit_cast(s16x8, sp));
                    mfma32_t(sc, kf[s], qf[s]); }
                asm volatile("s_nop 15" : "+v"(sc), "+v"(oacc) : "v"(qf[0]), "v"(qf[1]), "v"(qf[2]), "v"(qf[3]), "v"(kf[0]), "v"(kf[1]), "v"(kf[2]), "v"(kf[3]));
#pragma unroll
                for (int i = 0; i < 4; ++i) if (4 * g + i > x) sc[i] = 0.f;
                typedef unsigned u32x2 __attribute__((ext_vector_type(2)));
                const u32x2 pp = (u32x2){pkbf(sc[0], sc[1]), pkbf(sc[2], sc[3])};
                const s16x4 ppf = __builtin_bit_cast(s16x4, pp);
                mfma16_t(oacc, ppf, vf);
                asm volatile("s_nop 15" : "+v"(oacc));
                asm volatile("" : "+v"(oacc) : "v"(ppf), "v"(vf));
                { HLAS float* sq = (HLAS float*)(lds + OFF_SSQ) + (grp & 1) * 512 + w * 64 + 16 * c + 4 * g;
#pragma unroll
                  for (int i = 0; i < 4; ++i) { ow[(16 * c + 4 * g + i) * 16 + x] = (unsigned short)(pkbf(oacc[i], 0.f) & 0xffffu); const float s = row16_sum(oacc[i] * oacc[i]); if (x == 0) sq[i] = s; } }
            }
#pragma unroll
            for (int kt = 0; kt < 8; ++kt) {
                const s16x4 ka = *(const HLAS s16x4*)(pb + OFF_KT + (16 * kt) * ROWB + rr0 + c * 32);
                mfma16_t(S[kt], ka, vf); }
            asm volatile("s_nop 15" : "+v"(S[0]), "+v"(S[1]), "+v"(S[2]), "+v"(S[3]), "+v"(S[4]), "+v"(S[5]), "+v"(S[6]), "+v"(S[7]));
#pragma unroll
            for (int kt = 0; kt < 8; ++kt) S[kt] = S[kt] * *(const HLAS f32x4*)(pb + OFF_DCH + c * 512 + (16 * kt + 4 * g) * 4);
        }
    }
    if (FULL) { __syncthreads(); HG_FINALIZE(3); }
#undef HG_FINALIZE
#undef HG_LOADRAW
    if (!FULL) {
        typedef unsigned u32x2 __attribute__((ext_vector_type(2)));
        u32x2* L = (u32x2*)slabL + ((size_t)(unit * 8 + w) * 8) * 64 + lane;
#pragma unroll
        for (int kt = 0; kt < 8; ++kt) L[kt * 64] = (u32x2){pkbf(S[kt][0], S[kt][1]), pkbf(S[kt][2], S[kt][3])};
        HLAS float* tot = (HLAS float*)(lds + OFF_TOT);
        tot[pcg * 128 + pk] = tsum;
        __syncthreads();
        if (tid < 128) slabD[(size_t)unit * 128 + tid] = __expf(tot[tid] + tot[128 + tid] + tot[256 + tid] + tot[384 + tid]);
    } else if (n == NSC - 1) {
        float* so = state_out + ((size_t)(b * 4 + h) * 128) * 128 + 16 * w + x;
#pragma unroll
        for (int kt = 0; kt < 8; ++kt)
#pragma unroll
            for (int i = 0; i < 4; ++i) so[(size_t)(16 * kt + 4 * g + i) * 128] = S[kt][i];
    }
    __syncthreads();
}
#undef HLAS
}
#define GAS __attribute__((address_space(1)))
#define LAS __attribute__((address_space(3)))
typedef unsigned short bf16;
typedef unsigned v4u __attribute__((ext_vector_type(4)));
typedef float f32x4 __attribute__((ext_vector_type(4)));
typedef short bf16x8 __attribute__((ext_vector_type(8)));
typedef GAS unsigned gu32;
typedef GAS unsigned long long gu64;
#define RLX_AGENT __ATOMIC_RELAXED, __HIP_MEMORY_SCOPE_AGENT
#define LDS_WAIT() asm volatile("s_waitcnt lgkmcnt(0)" ::: "memory")
#define VM_WAIT() asm volatile("s_waitcnt vmcnt(0)" ::: "memory")
__device__ __forceinline__ unsigned long long rt() { return __builtin_amdgcn_s_memrealtime(); }
__device__ __forceinline__ unsigned f2bf(float f) { unsigned u = __builtin_bit_cast(unsigned, f); return (u + 0x7fffu + ((u >> 16) & 1u)) >> 16; }
__device__ __forceinline__ unsigned pk2(float lo, float hi) { return f2bf(lo) | (f2bf(hi) << 16); }

#define XB_TMO      128
#define XB_XCNT(j)  (256  + 64 * (j))
#define XB_XSUB(j)  (1280 + 64 * (j))
#define XB_XGEN(j)  (2304 + 64 * (j))
#define XB_TOP      3328
#define XB_TOPGEN   3392
#define XCD_BAR_WORDS 3456
#define XB_SPIN_CAP (1u << 18)

__device__ __forceinline__ unsigned xb_ld(unsigned* p)              { return __hip_atomic_load(p, __ATOMIC_RELAXED, __HIP_MEMORY_SCOPE_AGENT); }
__device__ __forceinline__ unsigned xb_add(unsigned* p, unsigned v) { return __hip_atomic_fetch_add(p, v, __ATOMIC_RELAXED, __HIP_MEMORY_SCOPE_AGENT); }
__device__ __forceinline__ unsigned xb_xcc_id() { return (unsigned)__builtin_amdgcn_s_getreg((3 << 11) | 20) & 0xFu; }
#define XB_SPIN(cond, bar) do { unsigned _sp = 0; while (cond) { __builtin_amdgcn_s_sleep(1); \
    if ((++_sp & 255u) == 0u) { if (xb_ld(&(bar)[XB_TMO])) break; if (_sp > XB_SPIN_CAP) { atomicAdd(&(bar)[XB_TMO], 1u); break; } } } } while (0)

struct XcdBarrier {
    unsigned* bar; unsigned x;
    volatile LAS unsigned* st;
};

__device__ __forceinline__ XcdBarrier xcd_barrier_post(unsigned* bar, volatile LAS unsigned* st) {
    XcdBarrier b; b.bar = bar; b.x = xb_xcc_id(); b.st = st;
    if (threadIdx.x == 0) (void)xb_add(&bar[XB_XCNT(b.x)], 1u);
    return b;
}
__device__ __forceinline__ void xcd_barrier_complete(unsigned* bar, unsigned x, unsigned& nloc, unsigned& nx) {
    const unsigned G = gridDim.x * gridDim.y * gridDim.z;
    unsigned sum, cnt, mine, sp = 0u;
    for (;;) {
        sum = 0u; cnt = 0u; mine = 0u;
#pragma unroll
        for (unsigned j = 0; j < 16; ++j) { const unsigned c = xb_ld(&bar[XB_XCNT(j)]); sum += c; cnt += (c > 0u) ? 1u : 0u; mine = (j == x) ? c : mine; }
        if (sum == G) break;
        __builtin_amdgcn_s_sleep(1);
        if ((++sp & 255u) == 0u) { if (xb_ld(&bar[XB_TMO])) break; if (sp > XB_SPIN_CAP) { atomicAdd(&bar[XB_TMO], 1u); break; } }
    }
    nloc = mine > 0u ? mine : 1u; nx = cnt > 0u ? cnt : 1u;
}

__device__ __forceinline__ void xcd_barrier(const XcdBarrier& b) {
    asm volatile("s_waitcnt vmcnt(0)" ::: "memory");
    __syncthreads();
    if (threadIdx.x == 0) {
        unsigned* bar = b.bar;
        __builtin_amdgcn_s_waitcnt(0);
        unsigned nloc = b.st[0], nx = b.st[1];
        if (nloc == 0u) { xcd_barrier_complete(bar, b.x, nloc, nx); b.st[0] = nloc; b.st[1] = nx; }
        const unsigned old = xb_add(&bar[XB_XSUB(b.x)], 1u);
        const unsigned gen = old / nloc;
        if (old + 1u == (gen + 1u) * nloc) {
            __builtin_amdgcn_fence(__ATOMIC_RELEASE, "agent");
            asm volatile("s_waitcnt vmcnt(0)" ::: "memory");
            const unsigned og = xb_add(&bar[XB_TOP], 1u);
            const unsigned tg = og / nx;
            if (og + 1u == (tg + 1u) * nx) xb_add(&bar[XB_TOPGEN], 1u);
            else XB_SPIN(xb_ld(&bar[XB_TOPGEN]) == tg, bar);
            __builtin_amdgcn_fence(__ATOMIC_ACQUIRE, "agent");
            xb_add(&bar[XB_XGEN(b.x)], 1u);
            asm volatile("s_waitcnt vmcnt(0)" ::: "memory");
        } else {
            XB_SPIN(xb_ld(&bar[XB_XGEN(b.x)]) == gen, bar);
            __builtin_amdgcn_fence(__ATOMIC_ACQUIRE, "agent");
            asm volatile("s_waitcnt vmcnt(0)" ::: "memory");
        }
    }
    __syncthreads();
}

struct Frame {
    LAS unsigned char* lds;
    volatile LAS unsigned* MISC;
    gu32* ctl;
    int tid, lane, wave, vcu, G;
    const float *xp, *xs, *cache_k, *cache_v, *state0; const int* ptab; const float *rel, *lbl;
    const float *n1, *wg1, *wu1, *wd1, *nmix, *win, *qn, *kn, *hn, *wout, *n2, *wg2, *wu2, *wd2;
    float* out;
    float *lb, *kmP, *kmS;
    bf16 *Wgu1, *Wd1, *Win, *Wout, *Wgu2, *Wd2, *XA, *MIX, *H, *QB, *KB, *VB;
    float *Dm, *D2, *D3, *X1, *X2, *REC, *Z, *GU, *GU2, *HL, *HD, *HF, *QS;
    bf16 *XA2, *XA3, *H2;
    float *SS0, *SS1, *SS2;
    bf16 *HQ, *HV, *HG;
    bf16* PO; float *PM, *PL, *TABG; int *LST, *CNT;
};
__device__ __forceinline__ float wave_sum(float v) {
#pragma unroll
    for (int o = 1; o < 64; o <<= 1) v += __shfl_xor(v, o);
    return v;
}
__device__ __forceinline__ float wave_max(float v) {
#pragma unroll
    for (int o = 1; o < 64; o <<= 1) v = fmaxf(v, __shfl_xor(v, o));
    return v;
}
__device__ __forceinline__ float silu_f(float x) { return x / (1.f + expf(-x)); }
__device__ __forceinline__ float bf2f(unsigned short u) { return __uint_as_float((unsigned)u << 16); }
__device__ __forceinline__ float sigmoid_f(float x) { return 1.f / (1.f + expf(-x)); }
template <int MODE>
__device__ __forceinline__ void p0_transpose_item(const float* W, const float* gain, int K, int N, bf16* WT, LAS float* scr, int item, int lane) {
    const int nblk = N / 32, kb = item / nblk, nb = item % nblk, k0 = 64 * kb, n0 = 32 * nb;
    const int rbase = MODE == 1 ? ((n0 & ~255) + 128 * ((n0 >> 5) & 1) + 32 * ((n0 >> 6) & 3)) : ((n0 >> 7) * 256 + (n0 & 127) + (MODE == 3 ? 128 : 0));
#pragma unroll 8
    for (int i = 0; i < 32; ++i) { const int kk = 2 * i + (lane >> 5); scr[kk * 33 + (lane & 31)] = W[(size_t)(k0 + kk) * N + n0 + (lane & 31)] * (gain ? gain[k0 + kk] : 1.f); }
    LDS_WAIT(); asm volatile("" ::: "memory");
    const int c = lane & 7;
#pragma unroll
    for (int j = 0; j < 4; ++j) { const int n = (lane >> 3) + 8 * j; const LAS float* s = scr + (8 * c) * 33 + n;
        v4u o; o.x = pk2(s[0 * 33], s[1 * 33]); o.y = pk2(s[2 * 33], s[3 * 33]); o.z = pk2(s[4 * 33], s[5 * 33]); o.w = pk2(s[6 * 33], s[7 * 33]);
        *(GAS v4u*)(WT + (size_t)(rbase + n) * K + k0 + 8 * c) = o; }
    LDS_WAIT(); asm volatile("" ::: "memory");
}
__device__ __forceinline__ const float* xrow(const Frame& F, int r) { return r < MP ? F.xp + (size_t)r * D : F.xs + (size_t)(r - MP) * D; }
__device__ __forceinline__ void rms_store_bf16(int lane, const f32x4 (&v)[4], const float* gain, bf16* orow) {
    float s = 0.f;
#pragma unroll
    for (int j = 0; j < 4; ++j) s += (v[j].x * v[j].x + v[j].y * v[j].y) + (v[j].z * v[j].z + v[j].w * v[j].w);
    const float rs = 1.f / sqrtf(wave_sum(s) * (1.f / D) + EPS);
    GAS unsigned long long* o8 = (GAS unsigned long long*)orow + lane;
#pragma unroll
    for (int j = 0; j < 4; ++j) { const f32x4 g = ((const GAS f32x4*)gain)[lane + 64 * j];
        o8[64 * j] = (unsigned long long)pk2(v[j].x * rs * g.x, v[j].y * rs * g.y) | ((unsigned long long)pk2(v[j].z * rs * g.z, v[j].w * rs * g.w) << 32); }
}
__device__ __forceinline__ void zero_row_bf16(int lane, bf16* orow) {
    GAS unsigned long long* o8 = (GAS unsigned long long*)orow + lane;
#pragma unroll
    for (int j = 0; j < 4; ++j) o8[64 * j] = 0ull;
}
__device__ __forceinline__ void p0_prologue(Frame& F) {
    LAS float* scr = (LAS float*)(F.lds + RING_OFF + F.wave * 16384);
    const int gw = F.vcu * NWAVES + F.wave, NGW = F.G * NWAVES;
    constexpr int I_G = (D / 64) * (FF / 32), I_D = (FF / 64) * (D / 32), I_IN = (D / 64) * (NIN / 32), I_O = (D / 64) * (D / 32);
    constexpr int NITEMS = 4 * I_G + 2 * I_D + I_IN + I_O;
    for (int it = gw; it < NITEMS; it += NGW) {
        int r = it;
        if (r < I_G) { p0_transpose_item<2>(F.wg1, F.n1, D, FF, F.Wgu1, scr, r, F.lane); continue; } r -= I_G;
        if (r < I_G) { p0_transpose_item<3>(F.wu1, F.n1, D, FF, F.Wgu1, scr, r, F.lane); continue; } r -= I_G;
        if (r < I_G) { p0_transpose_item<2>(F.wg2, F.n2, D, FF, F.Wgu2, scr, r, F.lane); continue; } r -= I_G;
        if (r < I_G) { p0_transpose_item<3>(F.wu2, F.n2, D, FF, F.Wgu2, scr, r, F.lane); continue; } r -= I_G;
        if (r < I_D) { p0_transpose_item<1>(F.wd1, nullptr, FF, D, F.Wd1, scr, r, F.lane); continue; } r -= I_D;
        if (r < I_D) { p0_transpose_item<1>(F.wd2, nullptr, FF, D, F.Wd2, scr, r, F.lane); continue; } r -= I_D;
        if (r < I_IN) { p0_transpose_item<1>(F.win, F.nmix, D, NIN, F.Win, scr, r, F.lane); continue; } r -= I_IN;
        p0_transpose_item<1>(F.wout, nullptr, D, D, F.Wout, scr, r, F.lane);
    }
    if (gw == 0) { for (int j = F.lane; j < 512; j += 64) F.lb[j] = sigmoid_f(F.lbl[j] - F.lbl[512 + j]); }
    for (int m = gw; m < M_ALL; m += NGW) {
        if (m < MR) { const GAS f32x4* xr = (const GAS f32x4*)xrow(F, m) + F.lane; GAS unsigned long long* o8 = (GAS unsigned long long*)(F.XA + (size_t)m * D) + F.lane; float s = 0.f;
#pragma unroll
            for (int j = 0; j < 4; ++j) { const f32x4 v = xr[64 * j]; s += (v.x * v.x + v.y * v.y) + (v.z * v.z + v.w * v.w); o8[64 * j] = (unsigned long long)pk2(v.x, v.y) | ((unsigned long long)pk2(v.z, v.w) << 32); }
            s = wave_sum(s); if (F.lane == 0) F.SS0[m] = s; }
        else { zero_row_bf16(F.lane, F.XA + (size_t)m * D); zero_row_bf16(F.lane, F.XA2 + (size_t)m * D); zero_row_bf16(F.lane, F.XA3 + (size_t)m * D); if (F.lane == 0) F.SS0[m] = 0.f; }
    }
}
constexpr int CW_Q1 = 1024, CW_Q3 = 1088;
__device__ __forceinline__ void kms_queue(Frame& F, int cw, int first, int count) {
    LAS f32x4* red = (LAS f32x4*)(F.lds + RING_OFF);
    LAS int* slot = (LAS int*)(F.lds + RING_OFF + 8192);
    int tq = F.tid; asm volatile("" : "+v"(tq)); const int rq = tq >> 7, c4 = tq & 127;
    for (;;) {
        if (F.tid == 0) slot[0] = (int)__hip_atomic_fetch_add((unsigned*)(F.ctl + cw), 1u, __ATOMIC_RELAXED, __HIP_MEMORY_SCOPE_AGENT);
        __syncthreads();
        const int q = slot[0];
        if (q >= count) break;
        const int it = first + q, sb = it / NBS, blk = it % NBS; f32x4 a = (f32x4){0.f, 0.f, 0.f, 0.f};
        const int page0 = F.ptab[sb * NPG + blk * 2], page1 = F.ptab[sb * NPG + blk * 2 + 1];
#pragma unroll
        for (int pg = 0; pg < 2; ++pg) { const GAS f32x4* base = (const GAS f32x4*)(F.cache_k + (size_t)(pg ? page1 : page0) * PAGE * AW) + c4 + rq * (AW / 4); f32x4 v[32];
#pragma unroll
            for (int s = 0; s < 32; ++s) v[s] = __builtin_nontemporal_load(base + (size_t)s * AW);
#pragma unroll
            for (int s = 0; s < 32; s += 2) a += v[s] + v[s + 1]; }
        red[rq * 128 + c4] = a;
        __syncthreads();
        if (F.tid < 128) { const f32x4 r = (red[F.tid] + red[128 + F.tid]) + (red[256 + F.tid] + red[384 + F.tid]); ((GAS f32x4*)(F.kmS + (size_t)it * AW))[F.tid] = r * (1.f / MOBA); }
        __syncthreads();
    }
    __syncthreads();
}
__device__ __forceinline__ int rel_bucket(int n) { return n < 16 ? n : min(31, 39 - __clz(n * n)); }
__device__ __forceinline__ void hgrn_prompt_phase1(Frame& F) {
    for (int u = F.vcu; u < PB * BH * hg::NSC; u += F.G)
        hg::hgrn_unit<false>(u >> 6, (u >> 4) & 3, u & 15, F.HQ, BW, F.HF, BW, F.HV, BW, F.HG, F.hn, F.MIX, F.HL, F.HD, F.out + OFF_SP, (__attribute__((address_space(3))) char*)(F.lds + RING_OFF));
}
__device__ __forceinline__ void hgrn_prompt_phase2(Frame& F) {
    for (int u = F.vcu; u < PB * BH * hg::NSC; u += F.G)
        hg::hgrn_unit<true>(u >> 6, (u >> 4) & 3, u & 15, F.HQ, BW, F.HF, BW, F.HV, BW, F.HG, F.hn, F.MIX, F.HL, F.HD, F.out + OFF_SP, (__attribute__((address_space(3))) char*)(F.lds + RING_OFF));
}
constexpr int CW_QA = 1152, CW_QB = 1216, CW_TOT = 2048;
constexpr int MB_PRE_OFF = RING_OFF + 118784, MB_SLOT_OFF = MB_PRE_OFF + 2304;
__device__ __forceinline__ void p0_tabg(Frame& F) {
    for (int i = (F.vcu * NWAVES + F.wave) * 64 + F.lane; i < AH * moba::TAB_N; i += F.G * NWAVES * 64) { const int h = i >> 12, d = i & 4095; F.TABG[h * moba::TAB_N + (moba::TAB_N - 1 - d)] = F.rel[rel_bucket(d) * AH + h] * moba::LOG2E; }
}
__device__ __forceinline__ void moba_select_item(Frame& F, int it) {
    const int b = it / 60, r_ = it % 60, n = 1 + (r_ >> 2), hp = r_ & 3;
    int tq = F.tid; asm volatile("" : "+v"(tq));
    const int half = tq >> 8, tl = tq & 255, h = 2 * hp + half, bh = b * AH + h, w4 = F.wave & 3;
    LAS float* kml = (LAS float*)(F.lds + RING_OFF);
    LAS int* wc = (LAS int*)(F.lds + RING_OFF + 8192);
    for (int i = tq; i < 2 * n * 16; i += NWAVES * 64) { const int hh = i / (n * 16), rem = i - hh * n * 16, nn = rem >> 4, c = rem & 15;
        *(LAS f32x4*)(kml + (hh * 15 + nn) * 64 + c * 4) = *(const GAS f32x4*)(F.kmP + ((size_t)(b * NBP + nn) * AW + (2 * hp + hh) * AD) + c * 4); }
    bf16x8 qv[8];
    { const bf16x8* qp = (const bf16x8*)(F.QB + (size_t)(b * PT + MOBA * n + tl) * AW + h * AD);
#pragma unroll
      for (int c = 0; c < 8; ++c) qv[c] = qp[c]; }
    __syncthreads();
    unsigned selm;
    if (n <= 3) selm = (1u << n) - 1u;
    else {
        float g0 = -INFINITY, g1 = -INFINITY, g2 = -INFINITY; int i0 = 0, i1 = 0, i2 = 0;
        for (int nn = 0; nn < n; ++nn) {
            const LAS float* km = kml + (half * 15 + nn) * 64;
            float a = 0.f;
#pragma unroll
            for (int c = 0; c < 8; ++c) { const f32x4 k0_ = *(const LAS f32x4*)(km + c * 8), k1_ = *(const LAS f32x4*)(km + c * 8 + 4);
#pragma unroll
                for (int j = 0; j < 4; ++j) { a += bf2f((unsigned short)qv[c][j]) * k0_[j]; a += bf2f((unsigned short)qv[c][4 + j]) * k1_[j]; } }
            const bool c0 = a > g0, c1 = a > g1, c2 = a > g2;
            g2 = c1 ? g1 : (c2 ? a : g2); i2 = c1 ? i1 : (c2 ? nn : i2);
            g1 = c0 ? g0 : (c1 ? a : g1); i1 = c0 ? i0 : (c1 ? nn : i1);
            g0 = c0 ? a : g0;             i0 = c0 ? nn : i0;
        }
        selm = (1u << i0) | (1u << i1) | (1u << i2);
    }
    for (int j = 0; j < n; ++j) { const unsigned long long bal = __ballot((selm >> j) & 1u); if (F.lane == 0) wc[(half * 16 + j) * 4 + w4] = (int)__popcll(bal); }
    __syncthreads();
    for (int j = 0; j < n; ++j) {
        const bool s_ = ((selm >> j) & 1u) != 0u; const unsigned long long bal = __ballot(s_);
        const LAS int* w_ = wc + (half * 16 + j) * 4; const int c0 = w_[0], c1 = w_[1], c2 = w_[2], c3 = w_[3];
        const int base = (w4 > 0 ? c0 : 0) + (w4 > 1 ? c1 : 0) + (w4 > 2 ? c2 : 0);
        if (s_) { const int pos = base + (int)__builtin_amdgcn_mbcnt_hi((unsigned)(bal >> 32), __builtin_amdgcn_mbcnt_lo((unsigned)bal, 0u)); const int slot = __popc(selm & ((1u << j) - 1u));
                  F.LST[(size_t)((bh * 15 + j) * 16 + n) * 256 + pos] = tl | (slot << 8); }
        if (tl == 0) { const int tot = c0 + c1 + c2 + c3; F.CNT[(bh * 15 + j) * 16 + n] = tot; (void)__hip_atomic_fetch_add((unsigned*)(F.ctl + CW_TOT + j * 32 + bh), (unsigned)tot, RLX_AGENT); }
    }
    __syncthreads();
}
__device__ __forceinline__ void moba_select_phase(Frame& F) {
    __syncthreads();
    for (int it = F.vcu; it < PB * 15 * 4; it += F.G) moba_select_item(F, it);
}
__device__ __forceinline__ void moba_tab_dma(Frame& F, int h, unsigned lds0) {
#pragma unroll
    for (int q = 0; q < 2; ++q) { const int ch = F.wave + 8 * q; moba::glds16(F.TABG + (size_t)h * moba::TAB_N + ch * 256 + F.lane * 4, (unsigned)__builtin_amdgcn_readfirstlane(lds0 + moba::LDS_TAB + ch * 1024)); }
}
__device__ __forceinline__ void moba_phaseA(Frame& F) {
    __syncthreads();
    char* shm = (char*)F.lds + RING_OFF;
    const unsigned lds0 = (unsigned)(uintptr_t)shm;
    LAS int* pre = (LAS int*)(F.lds + MB_PRE_OFF); LAS int* slot = (LAS int*)(F.lds + MB_SLOT_OFF);
    { const int e = F.tid; unsigned x = 0u; if (e < 480) { const unsigned tot = __hip_atomic_load((unsigned*)(F.ctl + CW_TOT + e), RLX_AGENT); x = (e >> 5) < 6 ? ((tot + 1023u) >> 10) : ((tot + 511u) >> 9); }
#pragma unroll
      for (int o = 1; o < 64; o <<= 1) { const unsigned v = __shfl_up(x, o); if (F.lane >= o) x += v; }
      if (F.lane == 63) pre[516 + F.wave] = (int)x;
      __syncthreads();
      unsigned add = 0u; for (int w = 0; w < F.wave; ++w) add += (unsigned)pre[516 + w];
      pre[e + 1] = (int)(x + add); if (e == 0) pre[0] = 0;
      __syncthreads(); }
    const int total = __builtin_amdgcn_readfirstlane(pre[480]);
    for (;;) {
        if (F.tid == 0) slot[0] = (int)__hip_atomic_fetch_add((unsigned*)(F.ctl + CW_QA), 1u, RLX_AGENT);
        __syncthreads();
        const int k = __builtin_amdgcn_readfirstlane(slot[0]);
        if (k >= total) break;
        int lo_ = 0, hi_ = 480;
        while (hi_ - lo_ > 1) { const int mid = (lo_ + hi_) >> 1; if (__builtin_amdgcn_readfirstlane(pre[mid]) <= k) lo_ = mid; else hi_ = mid; }
        const int e = lo_, c = k - __builtin_amdgcn_readfirstlane(pre[e]), j = e >> 5, bh = e & 31, b = bh >> 3, h = bh & 7;
        { int ln = F.lane; asm volatile("" : "+v"(ln));
          const bf16* ksrc = F.KB + ((size_t)b * PT + MOBA * j + ln) * AW + h * AD + F.wave * 8;
          const bf16* vsrc = F.VB + ((size_t)b * PT + MOBA * j + 16 * (F.wave & 3) + (ln >> 2)) * AW + h * AD + (F.wave >> 2) * 32 + (ln & 3) * 8;
          moba_tab_dma(F, h, lds0);
#pragma unroll
          for (int t = 0; t < 4; ++t) { moba::glds16(ksrc + (size_t)(64 * t) * AW, (unsigned)__builtin_amdgcn_readfirstlane(lds0 + moba::LDS_K + F.wave * 1024 + t * moba::SLOTB));
                                        moba::glds16(vsrc + (size_t)(64 * t) * AW, (unsigned)__builtin_amdgcn_readfirstlane(lds0 + moba::LDS_V + F.wave * 1024 + t * moba::SLOTB)); } }
        int cnt_l = 0; if (F.lane > j && F.lane < 16) cnt_l = F.CNT[(bh * 15 + j) * 16 + F.lane];
        int inc = cnt_l;
#pragma unroll
        for (int o = 1; o < 16; o <<= 1) { const int v = __shfl_up(inc, o); if (F.lane >= o) inc += v; }
        const int exc = inc - cnt_l, tot = __builtin_amdgcn_readlane(inc, 15), T = (tot + 31) >> 5, CH = j < 6 ? 32 : 16, gend = min(CH * c + CH, T);
        asm volatile("s_waitcnt vmcnt(0)" ::: "memory");
        __syncthreads();
        for (int g = CH * c + F.wave; g < gend; g += NWAVES) {
            const int p = 32 * g + (F.lane & 31), pc = p < tot ? p : tot - 1;
            int nsel = j + 1, idx = 0;
            for (int n = j + 1; n < 16; ++n) { const int on = __builtin_amdgcn_readlane(exc, n), cn = __builtin_amdgcn_readlane(cnt_l, n); if (pc >= on && pc < on + cn) { nsel = n; idx = pc - on; } }
            const int ent = F.LST[(size_t)((bh * 15 + j) * 16 + nsel) * 256 + idx];
            const int gq = MOBA * nsel + (ent & 255), sl = ent >> 8;
            const int grec = p < tot ? ((bh * 3 + sl) * PT + gq) : -1;
            moba::moba_core<8, true>(b, h, j, gq, grec, (const moba::bf16h*)F.QB, (const moba::bf16h*)F.KB, (const moba::bf16h*)F.VB, (moba::bf16h*)F.MIX, (moba::bf16h*)F.PO, F.PM, F.PL, shm);
        }
        __syncthreads();
    }
    __syncthreads();
}
__device__ __forceinline__ void moba_phaseB(Frame& F) {
    __syncthreads();
    char* shm = (char*)F.lds + RING_OFF;
    const unsigned lds0 = (unsigned)(uintptr_t)shm;
    LAS int* slot = (LAS int*)(F.lds + MB_SLOT_OFF);
    for (;;) {
        if (F.tid == 0) slot[0] = (int)__hip_atomic_fetch_add((unsigned*)(F.ctl + CW_QB), 1u, RLX_AGENT);
        __syncthreads();
        const int k = __builtin_amdgcn_readfirstlane(slot[0]);
        if (k >= PB * AH * NBP) break;
        const int bh = k >> 4, n = 15 - (k & 15), b = bh >> 3, h = bh & 7;
        moba_tab_dma(F, h, lds0);
        moba::moba_core<8, false>(b, h, n, 0, 0, (const moba::bf16h*)F.QB, (const moba::bf16h*)F.KB, (const moba::bf16h*)F.VB, (moba::bf16h*)F.MIX, (moba::bf16h*)F.PO, F.PM, F.PL, shm);
    }
    __syncthreads();
}
constexpr int SMP_SEL = 0, SMP_PART = 256, SMP_PSTR = 68;
__device__ __forceinline__ void moba_sample_unit(Frame& F, int sb, int h) {
    const int lane = F.lane, kq = lane >> 4, d4 = lane & 15, w = F.wave;
    const int relh = __float_as_int(F.rel[(lane & 31) * AH + h]);
    LAS int* sel = (LAS int*)(F.lds + RING_OFF + SMP_SEL);
    LAS float* part = (LAS float*)(F.lds + RING_OFF + SMP_PART);
    if (w < ST) {
        const int t = w; const f32x4* qp = (const f32x4*)(F.QS + (size_t)(sb * ST + t) * AW + h * AD); const f32x4* km = (const f32x4*)(F.kmS + (size_t)(sb * NBS + (lane & 31)) * AW + h * AD);
        float g = 0.f;
#pragma unroll
        for (int i = 0; i < 16; ++i) { const f32x4 q = qp[i], kv = km[i]; g += (q.x * kv.x + q.y * kv.y) + (q.z * kv.z + q.w * kv.w); }
        if (lane >= NBS) g = -INFINITY;
#pragma unroll
        for (int j = 0; j < 3; ++j) {
            float bv = g; int bi = lane;
#pragma unroll
            for (int o = 32; o >= 1; o >>= 1) { const float ov = __shfl_xor(bv, o); const int oi = __shfl_xor(bi, o); if (ov > bv || (ov == bv && oi < bi)) { bv = ov; bi = oi; } }
            if (lane == 0) sel[t * 4 + j] = bi;
            if (lane == bi) g = -INFINITY;
        }
    }
    __syncthreads();
    for (int ht = w; ht < 24; ht += NWAVES) {
        const int t = ht / 6, j = (ht % 6) >> 1, half = ht & 1, blk = sel[t * 4 + j];
        const int page = F.ptab[sb * NPG + blk * 2 + half];
        unsigned lo4 = (unsigned)(kq * (AW / 4) + d4); asm volatile("" : "+v"(lo4));
        const GAS f32x4* kb = (const GAS f32x4*)(F.cache_k + ((size_t)page * PAGE * AH + h) * AD) + lo4;
        const GAS f32x4* vb = (const GAS f32x4*)(F.cache_v + ((size_t)page * PAGE * AH + h) * AD) + lo4;
        const f32x4 q4 = *((const f32x4*)(F.QS + (size_t)(sb * ST + t) * AW + h * AD) + d4);
        const int dist0 = PAST + t - (blk * MOBA + half * PAGE + kq);
        float sv[32]; float m = -INFINITY;
#pragma unroll
        for (int i0 = 0; i0 < 32; i0 += 32) { f32x4 kv[32];
#pragma unroll
            for (int i = 0; i < 32; ++i) kv[i] = __builtin_nontemporal_load(kb + (unsigned)((i0 + i) * AW));
#pragma unroll
            for (int i = 0; i < 32; ++i) { float dt = (q4.x * kv[i].x + q4.y * kv[i].y) + (q4.z * kv[i].z + q4.w * kv[i].w);
                dt = hg::row16_sum(dt);
                const float s = dt * 0.125f + __int_as_float(__builtin_amdgcn_ds_bpermute(rel_bucket(dist0 - 4 * (i0 + i)) * 4, relh)); sv[i0 + i] = s; m = fmaxf(m, s); } }
        f32x4 vv0[16], vv1[16];
#pragma unroll
        for (int i = 0; i < 16; ++i) vv0[i] = __builtin_nontemporal_load(vb + (unsigned)(i * AW));
#pragma unroll
        for (int i = 0; i < 16; ++i) vv1[i] = __builtin_nontemporal_load(vb + (unsigned)((16 + i) * AW));
        m = fmaxf(m, __shfl_xor(m, 16)); m = fmaxf(m, __shfl_xor(m, 32));
        float l = 0.f;
#pragma unroll
        for (int i = 0; i < 32; ++i) { sv[i] = __expf(sv[i] - m); l += sv[i]; }
        l += __shfl_xor(l, 16); l += __shfl_xor(l, 32);
        f32x4 acc = (f32x4){0.f, 0.f, 0.f, 0.f};
        {
#pragma unroll
          for (int i = 0; i < 16; ++i) acc += vv0[i] * sv[i];
#pragma unroll
          for (int i = 0; i < 16; ++i) acc += vv1[i] * sv[16 + i]; }
#pragma unroll
        for (int c = 0; c < 4; ++c) { acc[c] += __shfl_xor(acc[c], 16); acc[c] += __shfl_xor(acc[c], 32); }
        LAS float* pp = part + ht * SMP_PSTR;
        if (lane < 16) *(LAS f32x4*)(pp + 4 + 4 * d4) = acc;
        if (lane == 0) { pp[0] = m; pp[1] = l; }
    }
    __syncthreads();
    if (w < ST) {
        const int t = w; const float* qp = F.QS + (size_t)(sb * ST + t) * AW + h * AD;
        float so[ST]; float mall = -INFINITY;
#pragma unroll
        for (int o = 0; o < ST; ++o) { so[o] = -INFINITY;
            if (o <= t) { const float dt = wave_sum(qp[lane] * F.out[OFF_KS + (size_t)(sb * ST + o) * AW + h * AD + lane]); so[o] = dt * 0.125f + F.rel[(t - o) * AH + h]; mall = fmaxf(mall, so[o]); } }
#pragma unroll
        for (int p = 0; p < 6; ++p) mall = fmaxf(mall, part[(6 * t + p) * SMP_PSTR]);
        float L = 0.f, o_ = 0.f;
#pragma unroll
        for (int p = 0; p < 6; ++p) { const LAS float* pp = part + (6 * t + p) * SMP_PSTR; const float wgt = __expf(pp[0] - mall); L += pp[1] * wgt; o_ += pp[4 + lane] * wgt; }
#pragma unroll
        for (int o = 0; o < ST; ++o) if (o <= t) { const float e = __expf(so[o] - mall); L += e; o_ += e * F.out[OFF_VS + (size_t)(sb * ST + o) * AW + h * AD + lane]; }
        F.MIX[(size_t)(MP + sb * ST + t) * D + h * AD + lane] = (bf16)f2bf(o_ / L);
    }
    __syncthreads();
}
__device__ __forceinline__ void hgrn_sample_unit(Frame& F, int seq, int h) {
    const int lane = F.lane, vi = lane >> 2, kc = lane & 3, w = F.wave, v = 16 * w + vi;
    LAS float* part = (LAS float*)(F.lds + RING_OFF);
    const unsigned sbase = (unsigned)(((seq * BH + h) * BKD + 32 * kc) * BVD + v);
    float S[32]; float ot[ST];
#pragma unroll
    for (int i = 0; i < 32; ++i) S[i] = F.state0[sbase + (unsigned)(i * BVD)];
#pragma unroll
    for (int t = 0; t < ST; ++t) {
        const unsigned r = (unsigned)(MP + seq * ST + t) * BW + h * BKD;
        const float vv = bf2f(F.HV[r + v]); float o = 0.f;
#pragma unroll
        for (int i4 = 0; i4 < 8; ++i4) { const unsigned long long qb4 = *(const unsigned long long*)(F.HQ + r + 32 * kc + 4 * i4); const f32x4 q = (f32x4){bf2f((unsigned short)qb4), bf2f((unsigned short)(qb4 >> 16)), bf2f((unsigned short)(qb4 >> 32)), bf2f((unsigned short)(qb4 >> 48))}, lf = *(const f32x4*)(F.HF + r + 32 * kc + 4 * i4);
#pragma unroll
            for (int j = 0; j < 4; ++j) { const float f = __expf(lf[j]); S[4 * i4 + j] = f * S[4 * i4 + j] + (1.f - f) * vv; o += S[4 * i4 + j] * q[j]; } }
        o += __shfl_xor(o, 1); o += __shfl_xor(o, 2); ot[t] = o;
        float s = o * o; s += __shfl_xor(s, 4); s += __shfl_xor(s, 8); s += __shfl_xor(s, 16); s += __shfl_xor(s, 32);
        if (lane == 0) part[t * 8 + w] = s;
    }
    float* const sout = F.out + OFF_SS;
#pragma unroll
    for (int i = 0; i < 32; ++i) sout[sbase + (unsigned)(i * BVD)] = S[i];
    __syncthreads();
    if (kc == 0) {
#pragma unroll
        for (int t = 0; t < ST; ++t) { float tot = 0.f;
#pragma unroll
            for (int ww = 0; ww < 8; ++ww) tot += part[t * 8 + ww];
            const unsigned r = (unsigned)(MP + seq * ST + t);
            const float y = ot[t] * (1.f / sqrtf(tot * (1.f / BVD) + EPS)) * F.hn[h * BVD + v] * bf2f(F.HG[r * BW + h * BVD + v]);
            F.MIX[(size_t)r * D + AW + h * BVD + v] = (bf16)f2bf(y); }
    }
    __syncthreads();
}
template <int PART> __device__ __forceinline__ void ph_mixers(Frame& F) {
#define SAMPLE_HGRN() do { if (F.G == PB * BH * hg::NSC) { if ((F.vcu & 15) < 8) { const int j = (F.vcu >> 4) * 8 + (F.vcu & 7); hgrn_sample_unit(F, j >> 2, j & 3); } } \
        else for (int u = F.vcu; u < SB * BH; u += F.G) hgrn_sample_unit(F, u >> 2, u & 3); } while (0)
    __syncthreads();
    if (F.G == SB * AH) {
        const int o = F.vcu >> 1; int ns = 0, s0 = 0, nhs = 0;
        if ((PART == 0) == ((F.vcu & 1) != 0)) { if (PART == 0) { if ((o & 3) != 3) { ns = 2; s0 = 2 * ((o >> 2) * 3 + (o & 3)); } else nhs = 4; } else if ((o & 1) == 0) { ns = 1; s0 = 192 + (o >> 1); } }
        else { hgrn_prompt_phase2(F); }
#pragma nounroll
        for (int i = 0; i < ns; ++i) moba_sample_unit(F, (s0 + i) >> 3, (s0 + i) & 7);
#pragma nounroll
        for (int i = 0; i < nhs; ++i) { const int j = 4 * (o >> 2) + i; hgrn_sample_unit(F, j >> 2, j & 3); }
    } else {
    if ((PART == 0) == ((F.vcu & 1) != 0)) { for (int u = F.vcu; u < SB * AH; u += F.G) moba_sample_unit(F, u >> 3, u & 7); }
    else { hgrn_prompt_phase2(F); SAMPLE_HGRN(); }
    }
    if (PART == 0) moba_phaseA(F); else moba_phaseB(F);
#undef SAMPLE_HGRN
}
constexpr int SRS_OFF = LDSCTL_OFF + 1024;
template <int K>
__device__ __forceinline__ void small_gemm(Frame& F, const bf16* A, const bf16* Bt, const float* base, float* xo, bf16* xa, float sc) {
    typedef float f32x4v __attribute__((ext_vector_type(4)));
    int lane = F.lane; asm volatile("" : "+v"(lane)); const int x = lane & 15, g = lane >> 4, kq = F.wave & 3; constexpr int KQ = K / 4, NS = KQ / 32;
    LAS f32x4v* red = (LAS f32x4v*)(F.lds + RING_OFF);
    for (int t0 = 2 * F.vcu; t0 < 512; t0 += 2 * F.G) {
        const int tile = t0 + (F.wave >> 2), rt = tile >> 6, st = tile & 63, col = 16 * st + x;
        const int wr_ = (col & ~255) + 128 * ((col >> 5) & 1) + 32 * ((col >> 6) & 3) + (col & 31);
        const bf16x8* ap = (const bf16x8*)(A + (size_t)(16 * rt + x) * K + kq * KQ + 8 * g); const bf16x8* bp = (const bf16x8*)(Bt + (size_t)wr_ * K + kq * KQ + 8 * g);
        f32x4v acc = (f32x4v){0.f, 0.f, 0.f, 0.f};
#pragma unroll
        for (int s0 = 0; s0 < NS; s0 += 11) { bf16x8 af[11], bfr[11];
#pragma unroll
            for (int s = 0; s < 11; ++s) if (s0 + s < NS) { af[s] = ap[(s0 + s) * 4]; bfr[s] = bp[(s0 + s) * 4]; }
#pragma unroll
            for (int s = 0; s < 11; ++s) if (s0 + s < NS) asm volatile("v_mfma_f32_16x16x32_bf16 %0, %1, %2, %0" : "+v"(acc) : "v"(af[s]), "v"(bfr[s])); }
        asm volatile("s_nop 15\n\ts_nop 15" : "+v"(acc));
        red[((F.wave >> 2) * 4 + kq) * 64 + lane] = acc;
        __syncthreads();
        if (kq == 0) { const LAS f32x4v* r = red + (F.wave >> 2) * 256 + lane; const f32x4v v = (r[0] + r[64]) + (r[128] + r[192]);
#pragma unroll
            for (int i = 0; i < 4; ++i) { const size_t o = (size_t)(16 * rt + 4 * g + i) * D + col; const float y = base[o] + sc * v[i]; xo[o] = y; if (xa) xa[o] = (bf16)f2bf(y); } }
        __syncthreads();
    }
}
__device__ __forceinline__ void sample_rs_to_lds(Frame& F, const float* X) {
    LAS float* tab = (LAS float*)(F.lds + SRS_OFF); int ln = F.lane; asm volatile("" : "+v"(ln));
    for (int r0 = 16 * F.wave; r0 < 16 * F.wave + 16; r0 += 8) {
        f32x4 v[8][4]; float s[8];
#pragma unroll
        for (int i = 0; i < 8; ++i)
#pragma unroll
            for (int j = 0; j < 4; ++j) v[i][j] = ((const GAS f32x4*)(X + (size_t)(r0 + i) * D) + ln)[64 * j];
#pragma unroll
        for (int i = 0; i < 8; ++i) { s[i] = 0.f;
#pragma unroll
            for (int j = 0; j < 4; ++j) s[i] += (v[i][j].x * v[i][j].x + v[i][j].y * v[i][j].y) + (v[i][j].z * v[i][j].z + v[i][j].w * v[i][j].w); }
#pragma unroll
        for (int o = 1; o < 64; o <<= 1)
#pragma unroll
            for (int i = 0; i < 8; ++i) s[i] += __shfl_xor(s[i], o);
#pragma unroll
        for (int i = 0; i < 8; ++i) if (ln == 0) tab[r0 + i] = 1.f / sqrtf(s[i] * (1.f / D) + EPS);
    }
    __syncthreads();
}

__device__ __forceinline__ void refresh(Frame& F) { int t = threadIdx.x; asm volatile("" : "+v"(t)); F.tid = t; F.lane = t & 63; }
constexpr int NPHASE = 10;
struct Args { const void* in[22]; float* out; unsigned char* ws; int ph_lo, ph_hi; };
__global__ void __launch_bounds__(NWAVES * 64, 2) mk_fwd(Args args) {
    extern __shared__ __attribute__((aligned(16))) unsigned char lds[];
    Frame F;
    F.lds = (LAS unsigned char*)lds;
    F.MISC = (volatile LAS unsigned*)(F.lds + MISC_OFF);
    F.tid = threadIdx.x; F.lane = F.tid & 63; F.wave = __builtin_amdgcn_readfirstlane(F.tid >> 6);
    F.G = gridDim.x; { const int bx = blockIdx.x; F.vcu = (F.G % 8 == 0) ? (bx % 8) * (F.G / 8) + bx / 8 : bx; }
    unsigned char* ws = args.ws;
    F.ctl = (gu32*)(ws + WS_CTL);
    F.xp = (const float*)args.in[0]; F.xs = (const float*)args.in[1]; F.cache_k = (const float*)args.in[2]; F.cache_v = (const float*)args.in[3]; F.state0 = (const float*)args.in[4];
    F.ptab = (const int*)args.in[5]; F.rel = (const float*)args.in[6]; F.lbl = (const float*)args.in[7];
    F.n1 = (const float*)args.in[8]; F.wg1 = (const float*)args.in[9]; F.wu1 = (const float*)args.in[10]; F.wd1 = (const float*)args.in[11];
    F.nmix = (const float*)args.in[12]; F.win = (const float*)args.in[13]; F.qn = (const float*)args.in[14]; F.kn = (const float*)args.in[15]; F.hn = (const float*)args.in[16];
    F.wout = (const float*)args.in[17]; F.n2 = (const float*)args.in[18]; F.wg2 = (const float*)args.in[19]; F.wu2 = (const float*)args.in[20]; F.wd2 = (const float*)args.in[21];
    F.out = args.out;
    F.lb = (float*)(ws + WS_SMALL); F.kmP = (float*)(ws + WS_CTL + 512 * 1024)  ; F.kmS = (float*)(ws + WS_KMS);
    F.Wgu1 = (bf16*)(ws + WS_WGU1); F.Wd1 = (bf16*)(ws + WS_WD1); F.Win = (bf16*)(ws + WS_WIN); F.Wout = (bf16*)(ws + WS_WOUT); F.Wgu2 = (bf16*)(ws + WS_WGU2); F.Wd2 = (bf16*)(ws + WS_WD2);
    F.QB = (bf16*)(ws + WS_QB); F.KB = (bf16*)(ws + WS_KB); F.VB = (bf16*)(ws + WS_VB);
    F.XA = (bf16*)(ws + WS_XA); F.MIX = (bf16*)(ws + WS_MIX); F.H = (bf16*)(ws + WS_H);
    F.Dm = (float*)(ws + WS_D); F.X1 = (float*)(ws + WS_X1); F.X2 = (float*)(ws + WS_X2); F.REC = (float*)(ws + WS_REC); F.Z = (float*)(ws + WS_Z); F.GU = (float*)(ws + WS_GU); F.HL = (float*)(ws + WS_HL); F.HD = (float*)(ws + WS_HD); F.HQ = (bf16*)(ws + WS_HQ); F.HF = (float*)(ws + WS_HF); F.QS = (float*)(ws + WS_QS);
    F.XA2 = (bf16*)(ws + WS_XA2); F.XA3 = (bf16*)(ws + WS_XA3); F.D2 = (float*)(ws + WS_D2); F.D3 = (float*)(ws + WS_D3); F.H2 = (bf16*)(ws + WS_H2); F.GU2 = (float*)(ws + WS_GU2); F.SS0 = (float*)(ws + WS_SS0); F.SS1 = (float*)(ws + WS_SS1); F.SS2 = (float*)(ws + WS_SS2); F.HV = (bf16*)(ws + WS_HV); F.HG = (bf16*)(ws + WS_HG);
    F.PO = (bf16*)(ws + WS_PO); F.PM = (float*)(ws + WS_PM); F.PL = (float*)(ws + WS_PL); F.LST = (int*)(ws + WS_LST); F.CNT = (int*)(ws + WS_CNT); F.TABG = (float*)(ws + WS_TABG);
    for (int u = F.tid; u < (LDS_BYTES - LDSCTL_OFF) / 4; u += NWAVES * 64) ((LAS unsigned*)(F.lds + LDSCTL_OFF))[u] = 0u;
    __syncthreads();
    const int lo = args.ph_lo, hi = args.ph_hi;
    XcdBarrier bar; bar.bar = (unsigned*)(F.ctl + CW_BAR); bar.x = 0; bar.st = nullptr;
    if (hi - lo > 1) bar = xcd_barrier_post((unsigned*)(F.ctl + CW_BAR), F.MISC + 8);
#define IN(k) (lo <= (k) && (k) < hi)
#define SEAM(k) do { if (IN(k) && IN((k) + 1)) xcd_barrier(bar); } while (0)
#define GEMM_PHASE(EPI, E_, Abuf, Wbuf, M_, N_, K_) do { pg8::Gemm g{Abuf, Wbuf, M_, N_, K_}; pg8::StaticOrder S; S.init(M_, N_, F.G, (int)blockIdx.x); \
        pg8::gemm_phase<EPI, pg8::StaticOrder, true, true>(F.lds + RING_OFF, g, S, E_); } while (0)
    if (IN(0)) { p0_prologue(F); p0_tabg(F); } SEAM(0);
    const LAS float* srs = (const LAS float*)(F.lds + SRS_OFF);
    if (IN(1)) { pg8::EpiSwiglu E{F.H, FF, pg8::RowRs{F.SS0, 1, nullptr, MP}}; GEMM_PHASE(pg8::EpiSwiglu, E, F.XA, F.Wgu1, M_ALL, NGU, D); kms_queue(F, CW_Q1, 0, 448); } SEAM(1);
    if (IN(2)) { pg8::EpiResid<false> E{F.xp, nullptr, F.XA2, F.SS1, 0.5f}; GEMM_PHASE(pg8::EpiResid<false>, E, F.H, F.Wd1, MP, D, FF);
                 small_gemm<FF>(F, F.H + (size_t)MP * FF, F.Wd1, F.xs, F.X1 + (size_t)MP * D, F.XA2 + (size_t)MP * D, 0.5f); } SEAM(2);
    if (IN(3)) { sample_rs_to_lds(F, F.X1 + (size_t)MP * D);
                 pg8::EpiProj E{pg8::RowRs{F.SS1, 16, srs, MP}, F.qn, F.kn, F.lb, F.QB, F.KB, F.VB, F.QS, F.out + OFF_KP, F.out + OFF_KS, F.out + OFF_VP, F.out + OFF_VS, F.kmP, F.HQ, F.HF, F.HV, F.HG, MP, MR, moba::C2};
                 GEMM_PHASE(pg8::EpiProj, E, F.XA2, F.Win, M_ALL, NIN, D); kms_queue(F, CW_Q3, 448, 576); } SEAM(3);
    if (IN(4)) { hgrn_prompt_phase1(F); moba_select_phase(F); } SEAM(4);
    if (IN(5)) { ph_mixers<0>(F); } SEAM(5);
    if (IN(6)) { ph_mixers<1>(F); } SEAM(6);
    if (IN(7)) { pg8::EpiResid<true> E{F.XA2, nullptr, F.XA3, F.SS2, 1.0f}; GEMM_PHASE(pg8::EpiResid<true>, E, F.MIX, F.Wout, MP, D, D);
                 small_gemm<D>(F, F.MIX + (size_t)MP * D, F.Wout, F.X1 + (size_t)MP * D, F.X2 + (size_t)MP * D, F.XA3 + (size_t)MP * D, 1.0f); } SEAM(7);
    if (IN(8)) { sample_rs_to_lds(F, F.X2 + (size_t)MP * D); pg8::EpiSwiglu E{F.H2, FF, pg8::RowRs{F.SS2, 16, srs, MP}}; GEMM_PHASE(pg8::EpiSwiglu, E, F.XA3, F.Wgu2, M_ALL, NGU, D); } SEAM(8);
    if (IN(9)) { pg8::EpiResid<true> E{F.XA3, F.out + OFF_YP, nullptr, nullptr, 0.5f}; GEMM_PHASE(pg8::EpiResid<true>, E, F.H2, F.Wd2, MP, D, FF);
                  small_gemm<FF>(F, F.H2 + (size_t)MP * FF, F.Wd2, F.X2 + (size_t)MP * D, F.out + OFF_YS, nullptr, 0.5f); }
#undef IN
#undef SEAM
#undef GEMM_PHASE
}

#ifndef MK_N_LAUNCHES
#define MK_N_LAUNCHES 1
#endif
extern "C" void kernel_launch(void* const* d_in, const int* in_sizes, int n_in, void* d_out, int out_size, void* d_ws, size_t ws_size, hipStream_t stream) {
    static int grid = 0;
    if (grid == 0) {
        if (n_in != 22 || out_size != (int)OUT_TOTAL || ws_size < WS_END) { fprintf(stderr, "kernel_launch: unexpected shapes (n_in %d, out %d, ws %zu); nothing launched\n", n_in, out_size, ws_size); grid = -1; return; }
        int dev = 0, cus = 0;
        if (hipGetDevice(&dev) != hipSuccess || hipDeviceGetAttribute(&cus, hipDeviceAttributeMultiprocessorCount, dev) != hipSuccess) { grid = -1; return; }
        if (hipFuncSetAttribute((const void*)mk_fwd, hipFuncAttributeMaxDynamicSharedMemorySize, LDS_BYTES) != hipSuccess) { fprintf(stderr, "kernel_launch: hipFuncSetAttribute failed\n"); grid = -1; return; }
        (void)hipGetLastError();
        grid = cus;
    }
    if (grid < 0) return;
    if (hipMemsetAsync((char*)d_ws + WS_CTL, 0, CTL_ZERO_BYTES, stream) != hipSuccess) return;
    Args a{};
    for (int i = 0; i < 22; ++i) a.in[i] = d_in[i];
    a.out = (float*)d_out; a.ws = (unsigned char*)d_ws;
    if (MK_N_LAUNCHES == 1) { a.ph_lo = 0; a.ph_hi = NPHASE; hipLaunchKernelGGL(mk_fwd, dim3(grid), dim3(NWAVES * 64), LDS_BYTES, stream, a); }
    else for (int p = 0; p < NPHASE; ++p) { a.ph_lo = p; a.ph_hi = p + 1; hipLaunchKernelGGL(mk_fwd, dim3(grid), dim3(NWAVES * 64), LDS_BYTES, stream, a); }
}
```
